# Optimizing an MI355X kernel written in HIP

```python
import math
import jax
import jax.numpy as jnp
from jax import lax
import numpy as np

D_MODEL = 1024
BATCH = 32
SEQ = 2048
DEPTH = 2
DEC_BATCH = 32
DEC_SEQ = 32
PAST_LEN = 1024

CHUNK = 64
N_EVEN = (DEPTH + 1) // 2
N_ODD = DEPTH // 2
FOX_HEAD_DIM = 64
FOX_HEADS = D_MODEL // 128
FOX_WIDTH = FOX_HEADS * FOX_HEAD_DIM
FORGET_BIAS = 3.0
POOL_WINDOWS = (2, 4, 8, 16)
POOL_GROUPS = len(POOL_WINDOWS)
POOL_WIDTH = D_MODEL // 2
POOL_GROUP_DIM = POOL_WIDTH // POOL_GROUPS
POOL_HIST = max(POOL_WINDOWS) - 1
EVEN_IN = 3 * FOX_WIDTH + FOX_HEADS + POOL_WIDTH
MIX_WIDTH = FOX_WIDTH + POOL_WIDTH
SGU_CHUNK = 128
SGU_WIDTH = D_MODEL
SGU_GROUPS = 8
SGU_GROUP_DIM = SGU_WIDTH // SGU_GROUPS
D_FF = ((8 * D_MODEL // 3) + 255) // 256 * 256
Q_BLOCK = 128
EPS = 1e-6

kernel_name = "fox_pool_sgu_macaron_stream_step"


def rms_norm(x, g):
    xf = x.astype(jnp.float32)
    y = xf * lax.rsqrt(jnp.mean(xf * xf, axis=-1, keepdims=True) + EPS)
    return (y * g.astype(jnp.float32)).astype(x.dtype)


def swiglu(h, w_in, w_down):
    gate, up = jnp.split(h @ w_in, 2, axis=-1)
    return (jax.nn.silu(gate) * up) @ w_down


def even_proj(h, w_in, b_f):
    B, T, _ = h.shape
    z = h @ w_in
    q = z[..., :FOX_WIDTH].reshape(B, T, FOX_HEADS, FOX_HEAD_DIM)
    k = z[..., FOX_WIDTH:2 * FOX_WIDTH].reshape(B, T, FOX_HEADS, FOX_HEAD_DIM)
    v = z[..., 2 * FOX_WIDTH:3 * FOX_WIDTH].reshape(B, T, FOX_HEADS, FOX_HEAD_DIM)
    f_logit = z[..., 3 * FOX_WIDTH:3 * FOX_WIDTH + FOX_HEADS] + b_f
    logf = jax.nn.log_sigmoid(f_logit.astype(jnp.float32))
    u = z[..., 3 * FOX_WIDTH + FOX_HEADS:]
    return q, k, v, logf, u


def fox_attend(q, cq, qpos, k, ck, kpos, v):
    s = jnp.einsum('bqhd,bkhd->bhqk', q, k).astype(jnp.float32) * (FOX_HEAD_DIM ** -0.5)
    s = s + jnp.transpose(cq, (0, 2, 1))[:, :, :, None] - jnp.transpose(ck, (0, 2, 1))[:, :, None, :]
    s = jnp.where(kpos[None, :] <= qpos[:, None], s, -jnp.inf)
    p = jax.nn.softmax(s, axis=-1)
    return jnp.einsum('bhqk,bkhd->bqhd', p.astype(v.dtype), v)


def fox_prompt(q, k, v, logf):
    B, S, H, Dh = q.shape
    c = jnp.cumsum(logf.astype(jnp.float32), axis=1)
    nb = S // Q_BLOCK
    pos = jnp.arange(S)
    qb = q.reshape(B, nb, Q_BLOCK, H, Dh).transpose(1, 0, 2, 3, 4)
    cb = c.reshape(B, nb, Q_BLOCK, H).transpose(1, 0, 2, 3)
    pb = pos.reshape(nb, Q_BLOCK)
    out = lax.map(lambda a: fox_attend(a[0], a[1], a[2], k, c, pos, v), (qb, cb, pb))
    return out.transpose(1, 0, 2, 3, 4).reshape(B, S, H * Dh)


def fox_sample(q, k, v, logf, k_past, v_past, logf_past):
    B, T, H, Dh = q.shape
    P = k_past.shape[1]
    k_all = jnp.concatenate([k_past, k], axis=1)
    v_all = jnp.concatenate([v_past, v], axis=1)
    c = jnp.cumsum(jnp.concatenate([logf_past.astype(jnp.float32), logf], axis=1), axis=1)
    kpos = jnp.arange(P + T)
    qpos = P + jnp.arange(T)
    out = fox_attend(q, c[:, P:], qpos, k_all, c, kpos, v_all)
    return out.reshape(B, T, H * Dh)


def pool_mix(u_ext, pos, w_grp, scale):
    B = u_ext.shape[0]
    T = pos.shape[0]
    uf = u_ext.astype(jnp.float32)
    cs = jnp.cumsum(jnp.pad(uf, ((0, 0), (1, 0), (0, 0))), axis=1)
    end = cs[:, POOL_HIST + 1:]
    u_new = uf[:, POOL_HIST:]
    outs = []
    for g, w in enumerate(POOL_WINDOWS):
        sl = slice(g * POOL_GROUP_DIM, (g + 1) * POOL_GROUP_DIM)
        win_sum = end[:, :, sl] - cs[:, POOL_HIST + 1 - w:POOL_HIST + 1 - w + T, sl]
        cnt = jnp.minimum(w, pos + 1).astype(jnp.float32)[None, :, None]
        outs.append(win_sum / cnt - u_new[:, :, sl])
    d = jnp.stack(outs, axis=2)
    y = jnp.einsum('btgc,gcd->btgd', d, w_grp.astype(jnp.float32)).reshape(B, T, POOL_WIDTH)
    return (y * scale.astype(jnp.float32)).astype(u_ext.dtype)


def sgu_mask(n):
    idx = jnp.arange(n) // CHUNK
    return idx[None, :] <= idx[:, None]


def sgu_proj(h, w_in, norm_g):
    zu, zv = jnp.split(jax.nn.gelu(h @ w_in), 2, axis=-1)
    return zu, rms_norm(zv, norm_g)


def sgu_prompt(zu, zv, w_s, b_s):
    B, S, _ = zu.shape
    n = S // SGU_CHUNK
    w = jnp.where(sgu_mask(SGU_CHUNK)[None], w_s, 0)
    vb = zv.reshape(B, n, SGU_CHUNK, SGU_GROUPS, SGU_GROUP_DIM)
    mix = jnp.einsum('gts,bnsgc->bntgc', w, vb) + b_s.T[:, :, None]
    return zu * mix.reshape(B, S, SGU_WIDTH)


def sgu_sample(zu, zv, w_s, b_s):
    B, T, _ = zu.shape
    w = jnp.where(sgu_mask(T)[None], w_s[:, :T, :T], 0)
    vb = zv.reshape(B, T, SGU_GROUPS, SGU_GROUP_DIM)
    mix = jnp.einsum('gts,bsgc->btgc', w, vb) + b_s[:, :T].T[:, :, None]
    return zu * mix.reshape(B, T, SGU_WIDTH)


def setup_inputs(seed: int = 0) -> dict:
    key = jax.random.key(seed)
    ks = jax.random.split(key, 20)
    f32 = jnp.float32

    def nrm(k, shape, scale):
        return jax.random.normal(k, shape, f32) * scale

    return {
        "x_prompt": nrm(ks[0], (BATCH, SEQ, D_MODEL), 1.0),
        "x_sample": nrm(ks[1], (DEC_BATCH, DEC_SEQ, D_MODEL), 1.0),
        "cache_k": nrm(ks[2], (N_EVEN, DEC_BATCH, PAST_LEN, FOX_HEADS, FOX_HEAD_DIM), 1.0),
        "cache_v": nrm(ks[3], (N_EVEN, DEC_BATCH, PAST_LEN, FOX_HEADS, FOX_HEAD_DIM), 1.0),
        "cache_logf": jax.nn.log_sigmoid(FORGET_BIAS + nrm(ks[4], (N_EVEN, DEC_BATCH, PAST_LEN, FOX_HEADS), 0.5)),
        "state_pool": nrm(ks[5], (N_EVEN, DEC_BATCH, POOL_HIST, POOL_WIDTH), 1.0),
        "norm_g": 1.0 + nrm(ks[6], (DEPTH, 3, D_MODEL), 0.05),
        "ffn_w_in": nrm(ks[7], (DEPTH, 2, D_MODEL, 2 * D_FF), D_MODEL ** -0.5),
        "ffn_w_down": nrm(ks[8], (DEPTH, 2, D_FF, D_MODEL), D_FF ** -0.5),
        "even_w_in": nrm(ks[9], (N_EVEN, D_MODEL, EVEN_IN), D_MODEL ** -0.5),
        "even_b_f": FORGET_BIAS + nrm(ks[10], (N_EVEN, FOX_HEADS), 0.5),
        "pool_w": nrm(ks[11], (N_EVEN, POOL_GROUPS, POOL_GROUP_DIM, POOL_GROUP_DIM), POOL_GROUP_DIM ** -0.5),
        "pool_scale": 1.0 + nrm(ks[12], (N_EVEN, POOL_WIDTH), 0.1),
        "even_w_out": nrm(ks[13], (N_EVEN, MIX_WIDTH, D_MODEL), MIX_WIDTH ** -0.5),
        "sgu_w_in": nrm(ks[14], (N_ODD, D_MODEL, 2 * SGU_WIDTH), D_MODEL ** -0.5),
        "sgu_norm_g": 1.0 + nrm(ks[15], (N_ODD, SGU_WIDTH), 0.05),
        "sgu_w_s": nrm(ks[16], (N_ODD, SGU_GROUPS, SGU_CHUNK, SGU_CHUNK), SGU_CHUNK ** -0.5),
        "sgu_b_s": 1.0 + nrm(ks[17], (N_ODD, SGU_GROUPS, SGU_CHUNK), 0.1),
        "sgu_w_out": nrm(ks[18], (N_ODD, SGU_WIDTH, D_MODEL), SGU_WIDTH ** -0.5),
        "final_g": 1.0 + nrm(ks[19], (D_MODEL,), 0.05),
    }


def reference(x_prompt, x_sample, cache_k, cache_v, cache_logf, state_pool, norm_g, ffn_w_in, ffn_w_down,
              even_w_in, even_b_f, pool_w, pool_scale, even_w_out, sgu_w_in, sgu_norm_g, sgu_w_s, sgu_b_s,
              sgu_w_out, final_g):
    xp, xs = x_prompt, x_sample
    B, S, _ = xp.shape
    Bs, T, _ = xs.shape
    P = cache_k.shape[2]
    pos_p = jnp.arange(S)
    pos_s = P + jnp.arange(T)
    kp_l, vp_l, fp_l, up_l = [], [], [], []
    ks_l, vs_l, fs_l, us_l, zs_l = [], [], [], [], []
    for l in range(DEPTH):
        xp = xp + 0.5 * swiglu(rms_norm(xp, norm_g[l, 0]), ffn_w_in[l, 0], ffn_w_down[l, 0])
        xs = xs + 0.5 * swiglu(rms_norm(xs, norm_g[l, 0]), ffn_w_in[l, 0], ffn_w_down[l, 0])
        hp = rms_norm(xp, norm_g[l, 1])
        hs = rms_norm(xs, norm_g[l, 1])
        if l % 2 == 0:
            e = l // 2
            q, k, v, lf, u = even_proj(hp, even_w_in[e], even_b_f[e])
            att = fox_prompt(q, k, v, lf)
            u_ext = jnp.concatenate([jnp.zeros((B, POOL_HIST, POOL_WIDTH), u.dtype), u], axis=1)
            pool = pool_mix(u_ext, pos_p, pool_w[e], pool_scale[e])
            xp = xp + jnp.concatenate([att, pool], axis=-1) @ even_w_out[e]
            kp_l.append(k); vp_l.append(v); fp_l.append(lf); up_l.append(u_ext[:, -POOL_HIST:])
            q, k, v, lf, u = even_proj(hs, even_w_in[e], even_b_f[e])
            att = fox_sample(q, k, v, lf, cache_k[e], cache_v[e], cache_logf[e])
            u_ext = jnp.concatenate([state_pool[e], u], axis=1)
            pool = pool_mix(u_ext, pos_s, pool_w[e], pool_scale[e])
            xs = xs + jnp.concatenate([att, pool], axis=-1) @ even_w_out[e]
            ks_l.append(k); vs_l.append(v); fs_l.append(lf); us_l.append(u_ext[:, -POOL_HIST:])
        else:
            o = l // 2
            zu, zv = sgu_proj(hp, sgu_w_in[o], sgu_norm_g[o])
            xp = xp + sgu_prompt(zu, zv, sgu_w_s[o], sgu_b_s[o]) @ sgu_w_out[o]
            zu, zv = sgu_proj(hs, sgu_w_in[o], sgu_norm_g[o])
            xs = xs + sgu_sample(zu, zv, sgu_w_s[o], sgu_b_s[o]) @ sgu_w_out[o]
            zs_l.append(zv)
        xp = xp + 0.5 * swiglu(rms_norm(xp, norm_g[l, 2]), ffn_w_in[l, 1], ffn_w_down[l, 1])
        xs = xs + 0.5 * swiglu(rms_norm(xs, norm_g[l, 2]), ffn_w_in[l, 1], ffn_w_down[l, 1])
    y_prompt = rms_norm(xp, final_g)
    y_sample = rms_norm(xs, final_g)
    return (y_prompt, y_sample, jnp.stack(kp_l), jnp.stack(vp_l), jnp.stack(fp_l), jnp.stack(up_l),
            jnp.stack(ks_l), jnp.stack(vs_l), jnp.stack(fs_l), jnp.stack(us_l), jnp.stack(zs_l))
```

```cpp
#include <hip/hip_runtime.h>
#include <hip/hip_cooperative_groups.h>
#include <cstdio>
#include <cstdint>
namespace cg = cooperative_groups;

#define LAS __attribute__((address_space(3)))
typedef unsigned short bf16_t;
typedef short bf16x8 __attribute__((ext_vector_type(8)));
typedef float f32x4 __attribute__((ext_vector_type(4)));
typedef float f32x16 __attribute__((ext_vector_type(16)));
typedef unsigned u32x4 __attribute__((ext_vector_type(4)));
typedef unsigned u32x2 __attribute__((ext_vector_type(2)));

constexpr int DM = 1024, MP = 65536, MS = 1024, MT = MP + MS, DFF = 2816, NFF = 5632;
constexpr int SEQ = 2048, TS = 32, PAST = 1024;
constexpr float EPS = 1e-6f, LOG2E = 1.4426950408889634f, QSCALE = 0.125f * 1.4426950408889634f;
constexpr size_t OFF_Y = 0, OFF_KP = 68157440, OFF_VP = 101711872, OFF_FP = 135266304, OFF_PP = 135790592,
                 OFF_KS = 136036352, OFF_VS = 136560640, OFF_FS = 137084928, OFF_PS = 137093120, OFF_ZS = 137338880;
constexpr size_t WS_W1 = 0;
constexpr size_t WS_W2 = WS_W1 + (size_t)4 * NFF * DM * 2;
constexpr size_t WS_WEIN = WS_W2 + (size_t)4 * DM * DFF * 2;
constexpr size_t WS_WF = WS_WEIN + (size_t)2048 * DM * 2;
constexpr size_t WS_WEOUT = WS_WF + (size_t)16 * DM * 2;
constexpr size_t WS_WSIN = WS_WEOUT + (size_t)DM * DM * 2;
constexpr size_t WS_WSOUT = WS_WSIN + (size_t)2048 * DM * 2;
constexpr size_t WS_POOLWT = WS_WSOUT + (size_t)DM * DM * 2;
constexpr size_t WS_SGUW = WS_POOLWT + (size_t)4 * 128 * 128 * 2;
constexpr size_t WS_SS = WS_SGUW + (size_t)8 * 128 * 128 * 2;
constexpr size_t WS_SS2 = WS_SS + (size_t)MT * 16 * 4;
constexpr size_t WS_XB = WS_SS2 + (size_t)MT * 16 * 4;
constexpr size_t WS_MIX = WS_XB + (size_t)MT * DM * 2;
constexpr size_t WS_R1 = WS_MIX + (size_t)MT * DM * 2;
constexpr size_t WS_BAR = WS_R1 + (size_t)MT * DFF * 2;
constexpr size_t WS_END = WS_BAR + 16384;
constexpr int LDS_BYTES = 147456;

struct Args {
    const float* in[20];
    float* out;
    unsigned char* ws;
};

typedef float f32x2_t __attribute__((ext_vector_type(2))); typedef __bf16 bf16x2_t __attribute__((ext_vector_type(2)));
__device__ __forceinline__ unsigned pk_bf16(float lo, float hi) { const f32x2_t v = {lo, hi}; const bf16x2_t b = __builtin_convertvector(v, bf16x2_t); return __builtin_bit_cast(unsigned, b); }
__device__ __forceinline__ int fresh_tid() { int t = threadIdx.x; asm volatile("" : "+v"(t)); return t; }
__device__ __forceinline__ float bf_lo(unsigned w) { return __uint_as_float(w << 16); }
__device__ __forceinline__ float bf_hi(unsigned w) { return __uint_as_float(w & 0xffff0000u); }
__device__ __forceinline__ float fexp2(float x) { return __builtin_amdgcn_exp2f(x); }
__device__ __forceinline__ float frcp(float x) { return __builtin_amdgcn_rcpf(x); }
__device__ __forceinline__ float wave_sum(float v) {
#pragma unroll
    for (int o = 1; o < 64; o <<= 1) v += __shfl_xor(v, o);
    return v;
}
__device__ __forceinline__ float row_rstd(const float* SS, int row) {
    const f32x4* p = (const f32x4*)(SS + (size_t)row * 16);
    const f32x4 a = p[0], b = p[1], c = p[2], d = p[3];
    const float s = ((a.x + a.y) + (a.z + a.w)) + ((b.x + b.y) + (b.z + b.w)) + ((c.x + c.y) + (c.z + c.w)) + ((d.x + d.y) + (d.z + d.w));
    return rsqrtf(s * (1.0f / 1024.0f) + EPS);
}
typedef float f32x2 __attribute__((ext_vector_type(2)));
__device__ __forceinline__ f32x2 swiglu2(f32x2 g, f32x2 u, float k1, float rs2) {
    const f32x2 a = g * k1; f32x2 e; e.x = fexp2(a.x); e.y = fexp2(a.y);
    const f32x2 d = e + 1.0f; f32x2 r; r.x = frcp(d.x); r.y = frcp(d.y);
    return (g * u) * (r * rs2);
}
__device__ __forceinline__ f32x2 gelu2(f32x2 x) {
    const f32x2 p = (x * x) * 0.044715f + 1.0f; const f32x2 a = (x * p) * (-LOG2E * 1.5957691216057308f);
    f32x2 e; e.x = fexp2(a.x); e.y = fexp2(a.y); const f32x2 d = e + 1.0f; f32x2 r; r.x = frcp(d.x); r.y = frcp(d.y);
    return x * r;
}
__device__ __forceinline__ float silu_mul(float g, float u) { return g * frcp(1.0f + fexp2(-LOG2E * g)) * u; }
__device__ __forceinline__ float gelu_tanh(float x) { const float t = x + 0.044715f * x * x * x; return x * frcp(1.0f + fexp2(-LOG2E * 1.5957691216057308f * t)); }

namespace pg8 {
#define PG8_LAS __attribute__((address_space(3)))
constexpr int BM = 256, BK = 64, HALF = 128, HTB = HALF * BK * 2, STAGE_BYTES = 8 * HTB, NXCD = 8, WGM = 8;
__host__ __device__ __forceinline__ int lds_byte(int r, int c) { const int st = (r >> 4) * 2 + (c >> 5), rr = r & 15, cc = c & 31, ob = rr * 64 + cc * 2; return st * 1024 + (ob ^ (((ob >> 9) & 1) << 5)); }
__host__ __device__ __forceinline__ void stage_rc(int b, int& R, int& C) { const int st = b / 1024, sb = b % 1024, swz = sb ^ (((sb >> 9) & 1) << 5); R = (st >> 1) * 16 + swz / 64; C = (st & 1) * 32 + (swz % 64) / 2; }
__host__ __device__ __forceinline__ int perm32(int rho) { const int n = rho >> 4, i = rho & 15; return 8 * (i >> 2) + 4 * n + (i & 3); }
struct Unit { int pm, pn; };
struct Gemm { const bf16_t* A; const bf16_t* Bt; int M, N, K; };
struct StaticOrder {
    int nM, nN, nwg, G, c;
    __host__ __device__ void init(int M, int N, int G_, int c_) { nM = M / BM; nN = N / BM; nwg = nM * nN; G = G_; c = c_; }
    __host__ __device__ bool next(int i, Unit& u) const {
        const long L = (long)i * G + c; if (L >= nwg) return false;
        int wgid = (int)L; { const int q = nwg / NXCD, r = nwg % NXCD, xcd = wgid % NXCD, off = wgid / NXCD; wgid = (xcd < r ? xcd * (q + 1) : r * (q + 1) + (xcd - r) * q) + off; }
        const int nig = WGM * nN, gid = wgid / nig, fm = gid * WGM, gsz = (nM - fm) < WGM ? (nM - fm) : WGM;
        u.pm = fm + ((wgid % nig) % gsz); u.pn = (wgid % nig) / gsz; return true;
    }
    __device__ __forceinline__ void a_ready(const Unit&) const {}
    __device__ __forceinline__ void done(const Unit&) const {}
};
template <class Epi, class Sched, bool ALIGN_EPI = false, bool SP2 = false>
__device__ __forceinline__ void gemm_phase(PG8_LAS unsigned char* lds, const Gemm g, const Sched& S, const Epi& E) {
    const int tid = fresh_tid(), wid = __builtin_amdgcn_readfirstlane(tid >> 6), lane = tid & 63, wr = wid >> 2, wc = wid & 3, fr = lane & 15, fq = lane >> 4;
    const int K = g.K, nt = K / BK;
    unsigned voffA[2], voffB[2];
#pragma unroll
    for (int i = 0; i < 2; ++i) { int R, C; stage_rc(tid * 16 + i * 8192, R, C); const int Rb = Epi::PERM ? ((R & ~31) + perm32(R & 31)) : R;
        voffA[i] = (unsigned)(R * K + C) * 2u; voffB[i] = (unsigned)(Rb * K + C) * 2u; }
    const size_t kstep = (size_t)(BK * 2);
    const size_t hstep = (size_t)HALF * K * 2;
    const size_t tstep = 2 * hstep;
    const unsigned ldsw = (unsigned)wid * 1024u;
    const int aoff = lds_byte(wr * 64 + fr, fq * 8), boff = lds_byte(wc * 32 + fr, fq * 8);
#define PG8_SA(b, h) (((b) * 2 + (h)) * HTB)
#define PG8_SB(b, h) ((4 + (b) * 2 + (h)) * HTB)
#define PG8_STAGE(bufoff, gbase, voff) do { _Pragma("unroll") for (int _i = 0; _i < 2; ++_i) \
        __builtin_amdgcn_global_load_lds((const unsigned*)((const char*)(gbase) + (voff)[_i]), (PG8_LAS unsigned*)(lds + (bufoff) + ldsw + _i * 8192), 16, 0, 0); } while (0)
#define PG8_LDA(dst, b, h) do { _Pragma("unroll") for (int m = 0; m < 4; ++m) _Pragma("unroll") for (int k = 0; k < 2; ++k) dst[m][k] = *(const PG8_LAS bf16x8*)(lds + PG8_SA(b, h) + aoff + m * 2048 + k * 1024); } while (0)
#define PG8_LDB(dst, b, h) do { _Pragma("unroll") for (int n = 0; n < 2; ++n) _Pragma("unroll") for (int k = 0; k < 2; ++k) dst[n][k] = *(const PG8_LAS bf16x8*)(lds + PG8_SB(b, h) + boff + n * 2048 + k * 1024); } while (0)
#define PG8_MMA(ai, bj, At, Bt) do { __builtin_amdgcn_s_setprio(1); _Pragma("unroll") for (int m = 0; m < 4; ++m) _Pragma("unroll") for (int n = 0; n < 2; ++n) _Pragma("unroll") for (int k = 0; k < 2; ++k) \
        acc[ai][bj][m][n] = __builtin_amdgcn_mfma_f32_16x16x32_bf16(Bt[n][k], At[m][k], acc[ai][bj][m][n], 0, 0, 0); __builtin_amdgcn_s_setprio(0); } while (0)
#define PG8_WAIT_V(n) asm volatile("s_waitcnt vmcnt(" #n ")" ::: "memory")
#define PG8_WAIT_L(n) asm volatile("s_waitcnt lgkmcnt(" #n ")" ::: "memory")
#define PG8_BAR __builtin_amdgcn_s_barrier()
#define PG8_SCHED __builtin_amdgcn_sched_barrier(0)
    PG8_LAS float* rsl = (PG8_LAS float*)(lds + STAGE_BYTES);
    f32x4 rq0, rq1, rq2, rq3;
#define PG8_RS_ISSUE(U) do { if (Epi::RS && tid < 256) { const f32x4* _p = (const f32x4*)(E.SS + (size_t)((U).pm * BM + tid) * 16); rq0 = _p[0]; rq1 = _p[1]; rq2 = _p[2]; rq3 = _p[3]; } } while (0)
#define PG8_RS_COMMIT(PAR) do { if (Epi::RS && tid < 256) { const float _s = (((rq0.x + rq0.y) + (rq0.z + rq0.w)) + ((rq1.x + rq1.y) + (rq1.z + rq1.w))) + (((rq2.x + rq2.y) + (rq2.z + rq2.w)) + ((rq3.x + rq3.y) + (rq3.z + rq3.w))); \
        rsl[(PAR) * 256 + tid] = rsqrtf(_s * (1.0f / 1024.0f) + 1e-6f); } } while (0)
    Unit cur, nxt; int ui = 0;
    if (!S.next(0, cur)) return;
    PG8_RS_ISSUE(cur); PG8_RS_COMMIT(0);
    f32x4 acc[2][2][4][2];
#pragma unroll
    for (int a = 0; a < 2; ++a)
#pragma unroll
        for (int b = 0; b < 2; ++b)
#pragma unroll
            for (int m = 0; m < 4; ++m)
#pragma unroll
                for (int n = 0; n < 2; ++n) acc[a][b][m][n] = (f32x4){0.f, 0.f, 0.f, 0.f};
    bf16x8 At[4][2], B0[2][2], B1[2][2];
    const char* cA = (const char*)g.A + (size_t)cur.pm * tstep; const char* cB = (const char*)g.Bt + (size_t)cur.pn * tstep;
    S.a_ready(cur);
    if constexpr (SP2) {
        PG8_STAGE(PG8_SB(0, 0), cB, voffB); PG8_STAGE(PG8_SB(0, 1), cB + hstep, voffB); PG8_STAGE(PG8_SA(0, 0), cA, voffA); PG8_STAGE(PG8_SA(0, 1), cA + hstep, voffA);
        if (wr == 1) PG8_BAR;
        PG8_WAIT_V(2); PG8_BAR;
        PG8_STAGE(PG8_SB(1, 0), cB + kstep, voffB); PG8_STAGE(PG8_SA(1, 0), cA + kstep, voffA); PG8_STAGE(PG8_SB(1, 1), cB + hstep + kstep, voffB);
        PG8_WAIT_V(6); PG8_BAR;
    } else {
        PG8_STAGE(PG8_SB(0, 0), cB, voffB); PG8_STAGE(PG8_SA(0, 0), cA, voffA); PG8_STAGE(PG8_SB(0, 1), cB + hstep, voffB); PG8_STAGE(PG8_SA(0, 1), cA + hstep, voffA);
        if (wr == 1) PG8_BAR;
        PG8_WAIT_V(4); PG8_BAR;
        PG8_STAGE(PG8_SB(1, 0), cB + kstep, voffB); PG8_STAGE(PG8_SA(1, 0), cA + kstep, voffA); PG8_STAGE(PG8_SB(1, 1), cB + hstep + kstep, voffB);
        PG8_WAIT_V(6); PG8_BAR;
    }
    for (;;) {
        const bool has_next = S.next(ui + 1, nxt);
        const char* nA = has_next ? (const char*)g.A + (size_t)nxt.pm * tstep : cA; const char* nB = has_next ? (const char*)g.Bt + (size_t)nxt.pn * tstep : cB;
        for (int t = 0; t < nt; t += 2) {
            const bool last = (t == nt - 2);
            const char* a1 = cA + (size_t)(t + 1) * kstep;
            const char* a2 = last ? nA : cA + (size_t)(t + 2) * kstep; const char* b2 = last ? nB : cB + (size_t)(t + 2) * kstep;
            const char* a3 = a2 + kstep; const char* b3 = b2 + kstep;
            if (last && has_next) { S.a_ready(nxt); PG8_RS_ISSUE(nxt); }
            if constexpr (SP2) {
            PG8_LDB(B0, 0, 0); PG8_LDB(B1, 0, 1); PG8_SCHED; PG8_LDA(At, 0, 0); PG8_STAGE(PG8_SA(1, 1), a1 + hstep, voffA);
            PG8_WAIT_V(8); PG8_WAIT_L(0); PG8_BAR; PG8_MMA(0, 0, At, B0); PG8_MMA(0, 1, At, B1); PG8_BAR; PG8_SCHED;
            PG8_LDA(At, 0, 1); PG8_STAGE(PG8_SB(0, 0), b2, voffB); PG8_STAGE(PG8_SB(0, 1), b2 + hstep, voffB); PG8_STAGE(PG8_SA(0, 0), a2, voffA);
            PG8_WAIT_V(8); PG8_WAIT_L(0); PG8_BAR; PG8_MMA(1, 0, At, B0); PG8_MMA(1, 1, At, B1); PG8_BAR; PG8_SCHED;
            PG8_LDB(B0, 1, 0); PG8_LDB(B1, 1, 1); PG8_SCHED; PG8_LDA(At, 1, 0); PG8_STAGE(PG8_SA(0, 1), a2 + hstep, voffA);
            PG8_WAIT_V(8); PG8_WAIT_L(0); PG8_BAR; PG8_MMA(0, 0, At, B0); PG8_MMA(0, 1, At, B1); PG8_BAR; PG8_SCHED;
            PG8_LDA(At, 1, 1); PG8_STAGE(PG8_SB(1, 0), b3, voffB); PG8_STAGE(PG8_SB(1, 1), b3 + hstep, voffB); PG8_STAGE(PG8_SA(1, 0), a3, voffA);
            PG8_WAIT_V(8); PG8_WAIT_L(0); PG8_BAR; PG8_MMA(1, 0, At, B0); PG8_MMA(1, 1, At, B1); PG8_BAR; PG8_SCHED;
            if (last && has_next) PG8_RS_COMMIT((ui + 1) & 1);
            } else {
            PG8_LDB(B0, 0, 0); PG8_SCHED; PG8_LDA(At, 0, 0); PG8_STAGE(PG8_SA(1, 1), a1 + hstep, voffA);
            PG8_WAIT_L(8); PG8_BAR; PG8_WAIT_L(0); PG8_MMA(0, 0, At, B0); PG8_BAR; PG8_SCHED;
            PG8_LDB(B1, 0, 1); PG8_STAGE(PG8_SB(0, 0), b2, voffB);
            PG8_BAR; PG8_WAIT_L(0); PG8_MMA(0, 1, At, B1); PG8_BAR;
            PG8_LDA(At, 0, 1); PG8_STAGE(PG8_SA(0, 0), a2, voffA);
            PG8_BAR; PG8_WAIT_L(0); PG8_MMA(1, 0, At, B0); PG8_BAR; PG8_SCHED;
            PG8_STAGE(PG8_SB(0, 1), b2 + hstep, voffB);
            PG8_WAIT_V(6); PG8_BAR; PG8_MMA(1, 1, At, B1); PG8_BAR;
            PG8_LDB(B0, 1, 0); PG8_SCHED; PG8_LDA(At, 1, 0); PG8_STAGE(PG8_SA(0, 1), a2 + hstep, voffA);
            PG8_WAIT_L(8); PG8_BAR; PG8_WAIT_L(0); PG8_MMA(0, 0, At, B0); PG8_BAR; PG8_SCHED;
            PG8_LDB(B1, 1, 1); PG8_STAGE(PG8_SB(1, 0), b3, voffB);
            PG8_BAR; PG8_WAIT_L(0); PG8_MMA(0, 1, At, B1); PG8_BAR;
            PG8_LDA(At, 1, 1); PG8_STAGE(PG8_SA(1, 0), a3, voffA);
            PG8_BAR; PG8_WAIT_L(0); PG8_MMA(1, 0, At, B0); PG8_BAR; PG8_SCHED;
            PG8_STAGE(PG8_SB(1, 1), b3 + hstep, voffB);
            PG8_WAIT_V(6); PG8_BAR; PG8_MMA(1, 1, At, B1); PG8_BAR;
            }
        }
        if constexpr (ALIGN_EPI) { if (wr == 0) PG8_BAR; }
        E(acc, cur, wr, wc, fr, fq, rsl + (ui & 1) * 256);
        if (!has_next) break;
#pragma unroll
        for (int a = 0; a < 2; ++a)
#pragma unroll
            for (int b = 0; b < 2; ++b)
#pragma unroll
                for (int m = 0; m < 4; ++m)
#pragma unroll
                    for (int n = 0; n < 2; ++n) acc[a][b][m][n] = (f32x4){0.f, 0.f, 0.f, 0.f};
        cur = nxt; cA = nA; cB = nB; ++ui;
        if constexpr (ALIGN_EPI) { if (wr == 1) PG8_BAR; }
    }
    PG8_WAIT_V(0);
    if constexpr (!ALIGN_EPI) { if (wr == 0) PG8_BAR; }
    PG8_BAR;
#undef PG8_RS_ISSUE
#undef PG8_RS_COMMIT
#undef PG8_SA
#undef PG8_SB
#undef PG8_STAGE
#undef PG8_LDA
#undef PG8_LDB
#undef PG8_MMA
#undef PG8_WAIT_V
#undef PG8_WAIT_L
#undef PG8_BAR
#undef PG8_SCHED
}

__device__ __forceinline__ void load_rstd8(const float* SS, int row0, int fq, float (&rs)[2][4]) {
    f32x4 t[2][4];
#pragma unroll
    for (int ai = 0; ai < 2; ++ai)
#pragma unroll
        for (int m = 0; m < 4; ++m) t[ai][m] = *(const f32x4*)(SS + (size_t)(row0 + ai * HALF + m * 16) * 16 + 4 * fq);
    asm volatile("" ::: "memory");
#pragma unroll
    for (int ai = 0; ai < 2; ++ai)
#pragma unroll
        for (int m = 0; m < 4; ++m) { float sm = (t[ai][m].x + t[ai][m].y) + (t[ai][m].z + t[ai][m].w); sm += __shfl_xor(sm, 16); sm += __shfl_xor(sm, 32);
            rs[ai][m] = rsqrtf(sm * (1.0f / 1024.0f) + EPS); }
}
struct EpiSwiGLU {
    static constexpr bool PERM = true, RS = true;
    bf16_t* O; const float* SS;
    __device__ __forceinline__ void operator()(const f32x4 (&acc)[2][2][4][2], const Unit& u, int wr, int wc, int fr, int fq, const PG8_LAS float* rsl) const {
        const int row0 = u.pm * BM + wr * 64 + fr; const int col0 = u.pn * 128 + wc * 32 + 8 * fq;
        float rsv[2][4];
#pragma unroll
        for (int ai = 0; ai < 2; ++ai)
#pragma unroll
            for (int m = 0; m < 4; ++m) rsv[ai][m] = rsl[ai * HALF + wr * 64 + m * 16 + fr];
#pragma unroll
        for (int ai = 0; ai < 2; ++ai)
#pragma unroll
            for (int m = 0; m < 4; ++m) {
                const int row = row0 + ai * HALF + m * 16; const float rs = rsv[ai][m], k1 = -LOG2E * rs, rs2 = rs * rs;
                const f32x4 g0 = acc[ai][0][m][0], g1 = acc[ai][0][m][1], u0 = acc[ai][1][m][0], u1 = acc[ai][1][m][1];
                const f32x2 o0 = swiglu2((f32x2){g0[0], g0[1]}, (f32x2){u0[0], u0[1]}, k1, rs2), o1 = swiglu2((f32x2){g0[2], g0[3]}, (f32x2){u0[2], u0[3]}, k1, rs2);
                const f32x2 o2 = swiglu2((f32x2){g1[0], g1[1]}, (f32x2){u1[0], u1[1]}, k1, rs2), o3 = swiglu2((f32x2){g1[2], g1[3]}, (f32x2){u1[2], u1[3]}, k1, rs2);
                u32x4 w;
                w.x = pk_bf16(o0.x, o0.y); w.y = pk_bf16(o1.x, o1.y); w.z = pk_bf16(o2.x, o2.y); w.w = pk_bf16(o3.x, o3.y);
                *(u32x4*)(O + (size_t)row * DFF + col0) = w;
            }
    }
};
struct EpiResidual {
    static constexpr bool PERM = true, RS = false;
    const float* baseP; const float* baseS; bf16_t* XB; float* SS; float alpha; int f32base;
    __device__ __forceinline__ void operator()(const f32x4 (&acc)[2][2][4][2], const Unit& u, int wr, int wc, int fr, int fq, const PG8_LAS float* rsl) const {
        const int row0 = u.pm * BM + wr * 64 + fr; const int colb = u.pn * BM + wc * 32 + 8 * fq;
        const bool samp = u.pm >= 256;
        if (f32base) {
#pragma unroll
            for (int ai = 0; ai < 2; ++ai)
#pragma unroll
                for (int mh = 0; mh < 2; ++mh) {
                    f32x4 fb[2][2][2];
#pragma unroll
                    for (int m2 = 0; m2 < 2; ++m2) { const int row = row0 + ai * HALF + (2 * mh + m2) * 16;
                        const float* bp = (samp ? baseS + (size_t)(row - MP) * DM : baseP + (size_t)row * DM) + colb;
#pragma unroll
                        for (int bj = 0; bj < 2; ++bj) { fb[m2][bj][0] = *(const f32x4*)(bp + bj * HALF); fb[m2][bj][1] = *(const f32x4*)(bp + bj * HALF + 4); } }
                    asm volatile("" : "+v"(fb[0][0][0]), "+v"(fb[0][0][1]), "+v"(fb[0][1][0]), "+v"(fb[0][1][1]), "+v"(fb[1][0][0]), "+v"(fb[1][0][1]), "+v"(fb[1][1][0]), "+v"(fb[1][1][1]) :: "memory");
#pragma unroll
                    for (int m2 = 0; m2 < 2; ++m2) { const int m = 2 * mh + m2; const int row = row0 + ai * HALF + m * 16; float ss = 0.f;
#pragma unroll
                        for (int bj = 0; bj < 2; ++bj) {
                            const f32x4 x0 = fb[m2][bj][0] + acc[ai][bj][m][0] * alpha, x1 = fb[m2][bj][1] + acc[ai][bj][m][1] * alpha;
                            u32x4 w; w.x = pk_bf16(x0[0], x0[1]); w.y = pk_bf16(x0[2], x0[3]); w.z = pk_bf16(x1[0], x1[1]); w.w = pk_bf16(x1[2], x1[3]);
                            *(u32x4*)(XB + (size_t)row * DM + colb + bj * HALF) = w;
                            ss += (x0[0] * x0[0] + x0[1] * x0[1]) + (x0[2] * x0[2] + x0[3] * x0[3]) + (x1[0] * x1[0] + x1[1] * x1[1]) + (x1[2] * x1[2] + x1[3] * x1[3]);
                        }
                        ss += __shfl_xor(ss, 16); ss += __shfl_xor(ss, 32);
                        if (fq == 0) SS[(size_t)row * 16 + u.pn * 4 + wc] = ss; }
                }
            return;
        }
#pragma unroll
        for (int ai = 0; ai < 2; ++ai) {
            u32x4 wv[4][2];
#pragma unroll
            for (int m = 0; m < 4; ++m)
#pragma unroll
                for (int bj = 0; bj < 2; ++bj) wv[m][bj] = *(const u32x4*)(XB + (size_t)(row0 + ai * HALF + m * 16) * DM + colb + bj * HALF);
            asm volatile("" : "+v"(wv[0][0]), "+v"(wv[0][1]), "+v"(wv[1][0]), "+v"(wv[1][1]), "+v"(wv[2][0]), "+v"(wv[2][1]), "+v"(wv[3][0]), "+v"(wv[3][1]) :: "memory");
#pragma unroll
            for (int m = 0; m < 4; ++m) {
                const int row = row0 + ai * HALF + m * 16;
                float ss = 0.f;
#pragma unroll
                for (int bj = 0; bj < 2; ++bj) {
                    const u32x4 wq = wv[m][bj];
                    const f32x4 b0 = (f32x4){bf_lo(wq.x), bf_hi(wq.x), bf_lo(wq.y), bf_hi(wq.y)}, b1 = (f32x4){bf_lo(wq.z), bf_hi(wq.z), bf_lo(wq.w), bf_hi(wq.w)};
                    const f32x4 x0 = b0 + acc[ai][bj][m][0] * alpha, x1 = b1 + acc[ai][bj][m][1] * alpha;
                    u32x4 w; w.x = pk_bf16(x0[0], x0[1]); w.y = pk_bf16(x0[2], x0[3]); w.z = pk_bf16(x1[0], x1[1]); w.w = pk_bf16(x1[2], x1[3]);
                    *(u32x4*)(XB + (size_t)row * DM + colb + bj * HALF) = w;
                    ss += (x0[0] * x0[0] + x0[1] * x0[1]) + (x0[2] * x0[2] + x0[3] * x0[3]) + (x1[0] * x1[0] + x1[1] * x1[1]) + (x1[2] * x1[2] + x1[3] * x1[3]);
                }
                ss += __shfl_xor(ss, 16); ss += __shfl_xor(ss, 32);
                if (fq == 0) SS[(size_t)row * 16 + u.pn * 4 + wc] = ss;
            }
        }
    }
};
struct EpiProjEven {
    static constexpr bool PERM = true, RS = true;
    bf16_t* QKVU; const float* SS; float* out;
    __device__ __forceinline__ void operator()(const f32x4 (&acc)[2][2][4][2], const Unit& u, int wr, int wc, int fr, int fq, const PG8_LAS float* rsl) const {
        const int sec = u.pn >> 1; const bool samp = u.pm >= 256;
        const int row0 = u.pm * BM + wr * 64 + fr; const int colb = u.pn * BM + wc * 32 + 8 * fq;
        float* o32 = nullptr;
        if (sec == 1) o32 = out + (samp ? OFF_KS : OFF_KP); else if (sec == 2) o32 = out + (samp ? OFF_VS : OFF_VP);
        float* opool = out + (samp ? OFF_PS : OFF_PP);
        const float qs = (sec == 0) ? QSCALE : 1.0f;
        float rsv[2][4];
#pragma unroll
        for (int ai = 0; ai < 2; ++ai)
#pragma unroll
            for (int m = 0; m < 4; ++m) rsv[ai][m] = rsl[ai * HALF + wr * 64 + m * 16 + fr];
#pragma unroll
        for (int ai = 0; ai < 2; ++ai)
#pragma unroll
            for (int m = 0; m < 4; ++m) {
                const int row = row0 + ai * HALF + m * 16; const float rs = rsv[ai][m] * qs;
                const int orow = samp ? row - MP : row;
                bool poolrow = false; int prow = 0;
                if (sec == 3) {
                    if (!samp) { const int t = row & 2047; poolrow = t >= 2033; prow = (row >> 11) * 15 + t - 2033; }
                    else { const int rr = row - MP, t = rr & 31; poolrow = t >= 17; prow = (rr >> 5) * 15 + t - 17; }
                }
#pragma unroll
                for (int bj = 0; bj < 2; ++bj) {
                    const int col = colb + bj * HALF;
                    const f32x4 v0 = acc[ai][bj][m][0] * rs, v1 = acc[ai][bj][m][1] * rs;
                    u32x4 w; w.x = pk_bf16(v0[0], v0[1]); w.y = pk_bf16(v0[2], v0[3]); w.z = pk_bf16(v1[0], v1[1]); w.w = pk_bf16(v1[2], v1[3]);
                    *(u32x4*)(QKVU + (size_t)row * 2048 + col) = w;
                    if (o32) { float* p = o32 + (size_t)orow * 512 + (col & 511); *(f32x4*)p = v0; *(f32x4*)(p + 4) = v1; }
                    if (poolrow) { float* p = opool + (size_t)prow * 512 + (col & 511); *(f32x4*)p = v0; *(f32x4*)(p + 4) = v1; }
                }
            }
    }
};
struct EpiSguProj {
    static constexpr bool PERM = true, RS = true;
    bf16_t* ZUV; const float* SS; float* SS2;
    __device__ __forceinline__ void operator()(const f32x4 (&acc)[2][2][4][2], const Unit& u, int wr, int wc, int fr, int fq, const PG8_LAS float* rsl) const {
        const int row0 = u.pm * BM + wr * 64 + fr; const int colb = u.pn * BM + wc * 32 + 8 * fq;
        const bool isv = u.pn >= 4;
        float rsv[2][4];
#pragma unroll
        for (int ai = 0; ai < 2; ++ai)
#pragma unroll
            for (int m = 0; m < 4; ++m) rsv[ai][m] = rsl[ai * HALF + wr * 64 + m * 16 + fr];
#pragma unroll
        for (int ai = 0; ai < 2; ++ai)
#pragma unroll
            for (int m = 0; m < 4; ++m) {
                const int row = row0 + ai * HALF + m * 16; const float rs = rsv[ai][m];
                float ss = 0.f;
#pragma unroll
                for (int bj = 0; bj < 2; ++bj) {
                    const int col = colb + bj * HALF;
                    f32x4 v0 = acc[ai][bj][m][0] * rs, v1 = acc[ai][bj][m][1] * rs;
                    { const f32x2 a0 = gelu2((f32x2){v0[0], v0[1]}), a1 = gelu2((f32x2){v0[2], v0[3]}), a2 = gelu2((f32x2){v1[0], v1[1]}), a3 = gelu2((f32x2){v1[2], v1[3]});
                      v0 = (f32x4){a0.x, a0.y, a1.x, a1.y}; v1 = (f32x4){a2.x, a2.y, a3.x, a3.y}; }
                    u32x4 w; w.x = pk_bf16(v0[0], v0[1]); w.y = pk_bf16(v0[2], v0[3]); w.z = pk_bf16(v1[0], v1[1]); w.w = pk_bf16(v1[2], v1[3]);
                    *(u32x4*)(ZUV + (size_t)row * 2048 + col) = w;
                    ss += (v0[0] * v0[0] + v0[1] * v0[1]) + (v0[2] * v0[2] + v0[3] * v0[3]) + (v1[0] * v1[0] + v1[1] * v1[1]) + (v1[2] * v1[2] + v1[3] * v1[3]);
                }
                if (isv) { ss += __shfl_xor(ss, 16); ss += __shfl_xor(ss, 32); if (fq == 0) SS2[(size_t)row * 16 + (u.pn - 4) * 4 + wc] = ss; }
            }
    }
};
}

__device__ __forceinline__ void p0_tr_item(const float* W, int ldw, int k0, int src_col0, bf16_t* WT, int K, int dst_row0, const float* gk, const float* sn, LAS float* scr, int lane) {
    const int c = lane & 7;
    f32x4 wq[8]; f32x4 ga = (f32x4){1.f, 1.f, 1.f, 1.f}, gb = ga;
    const float* wp = W + (size_t)(k0 + (lane >> 5)) * ldw + src_col0 + (lane & 31);
#pragma unroll
    for (int i = 0; i < 32; ++i) wq[i >> 2][i & 3] = wp[(size_t)(2 * i) * ldw];
    if (gk) { ga = *(const f32x4*)(gk + k0 + 8 * c); gb = *(const f32x4*)(gk + k0 + 8 * c + 4); }
    asm volatile("" : "+v"(wq[0]), "+v"(wq[1]), "+v"(wq[2]), "+v"(wq[3]), "+v"(wq[4]), "+v"(wq[5]), "+v"(wq[6]), "+v"(wq[7]), "+v"(ga), "+v"(gb) :: "memory");
#pragma unroll
    for (int i = 0; i < 32; ++i) scr[(2 * i + (lane >> 5)) * 33 + (lane & 31)] = wq[i >> 2][i & 3];
    asm volatile("s_waitcnt lgkmcnt(0)" ::: "memory");
#pragma unroll
    for (int j = 0; j < 4; ++j) { const int n = (lane >> 3) + 8 * j; const LAS float* sp = scr + (8 * c) * 33 + n; const float sc = sn ? sn[n] : 1.0f;
        u32x4 o; o.x = pk_bf16(sp[0 * 33] * ga.x * sc, sp[1 * 33] * ga.y * sc); o.y = pk_bf16(sp[2 * 33] * ga.z * sc, sp[3 * 33] * ga.w * sc);
        o.z = pk_bf16(sp[4 * 33] * gb.x * sc, sp[5 * 33] * gb.y * sc); o.w = pk_bf16(sp[6 * 33] * gb.z * sc, sp[7 * 33] * gb.w * sc);
        *(u32x4*)(WT + (size_t)(dst_row0 + n) * K + k0 + 8 * c) = o; }
    asm volatile("s_waitcnt lgkmcnt(0)" ::: "memory");
}

__device__ __forceinline__ void p0_phase(const Args& a, LAS unsigned char* lds) {
    const int tid = fresh_tid(), lane = tid & 63, wid = __builtin_amdgcn_readfirstlane(tid >> 6);
    const int gw = blockIdx.x * 8 + wid, NGW = gridDim.x * 8;
    unsigned char* ws = a.ws;
    LAS float* scr = (LAS float*)(lds + wid * 8704);
    const float* norm_g = a.in[6];
    for (int it = gw; it < 20000; it += NGW) {
        const float* W; int ldw, k0, sc0, K, dr0; bf16_t* WT; const float* gk = nullptr; const float* sn = nullptr;
        int r = it;
        if (r < 11264) { const int mi = r / 2816; r -= mi * 2816; const int kb = r / 176, nb = r % 176, n0 = nb * 32, pn = n0 >> 8, bj = (n0 >> 7) & 1, jj = n0 & 127;
            W = a.in[7] + (size_t)mi * DM * NFF; ldw = NFF; k0 = kb * 64; sc0 = bj * DFF + pn * 128 + jj; WT = (bf16_t*)(ws + WS_W1) + (size_t)mi * NFF * DM; K = DM; dr0 = n0;
            gk = norm_g + ((mi >> 1) * 3 + ((mi & 1) ? 2 : 0)) * DM; }
        else if ((r -= 11264) < 5632) { const int mi = r / 1408; r -= mi * 1408; const int kb = r / 32, nb = r % 32;
            W = a.in[8] + (size_t)mi * DFF * DM; ldw = DM; k0 = kb * 64; sc0 = nb * 32; WT = (bf16_t*)(ws + WS_W2) + (size_t)mi * DM * DFF; K = DFF; dr0 = nb * 32; }
        else if ((r -= 5632) < 1024) { const int kb = r / 64, nb = r % 64, n0 = nb * 32;
            W = a.in[9]; ldw = 2056; k0 = kb * 64; sc0 = n0 < 1536 ? n0 : n0 + 8; WT = (bf16_t*)(ws + WS_WEIN); K = DM; dr0 = n0; gk = norm_g + 1 * DM; }
        else if ((r -= 1024) < 512) { const int kb = r / 32, nb = r % 32;
            W = a.in[13]; ldw = DM; k0 = kb * 64; sc0 = nb * 32; WT = (bf16_t*)(ws + WS_WEOUT); K = DM; dr0 = nb * 32; }
        else if ((r -= 512) < 1024) { const int kb = r / 64, nb = r % 64;
            W = a.in[14]; ldw = 2048; k0 = kb * 64; sc0 = nb * 32; WT = (bf16_t*)(ws + WS_WSIN); K = DM; dr0 = nb * 32; gk = norm_g + 4 * DM; }
        else if ((r -= 1024) < 512) { const int kb = r / 32, nb = r % 32;
            W = a.in[18]; ldw = DM; k0 = kb * 64; sc0 = nb * 32; WT = (bf16_t*)(ws + WS_WSOUT); K = DM; dr0 = nb * 32; }
        else { r -= 512; const int g = r >> 3, kb = (r >> 2) & 1, nb = r & 3;
            W = a.in[11] + (size_t)g * 128 * 128; ldw = 128; k0 = kb * 64; sc0 = nb * 32; WT = (bf16_t*)(ws + WS_POOLWT) + (size_t)g * 128 * 128; K = 128; dr0 = nb * 32; sn = a.in[12] + g * 128 + nb * 32; }
        p0_tr_item(W, ldw, k0, sc0, WT, K, dr0, gk, sn, scr, lane);
    }
    const int gt = blockIdx.x * 512 + tid, NGT = gridDim.x * 512;
    { bf16_t* WF = (bf16_t*)(ws + WS_WF); const float* W = a.in[9];
      for (int idx = gt; idx < 16 * DM; idx += NGT) { const int rr = idx >> 10, k = idx & 1023; const float v = rr < 8 ? W[(size_t)k * 2056 + 1536 + rr] * norm_g[DM + k] : 0.f; WF[idx] = (bf16_t)(pk_bf16(v, 0.f) & 0xffffu); } }
    { bf16_t* SW = (bf16_t*)(ws + WS_SGUW); const float* W = a.in[16];
      for (int idx = gt; idx < 8 * 128 * 128; idx += NGT) { const int t = (idx >> 7) & 127, s = idx & 127; const float v = ((s >> 6) <= (t >> 6)) ? W[idx] : 0.f; SW[idx] = (bf16_t)(pk_bf16(v, 0.f) & 0xffffu); } }
    bf16_t* XB = (bf16_t*)(ws + WS_XB); float* SS = (float*)(ws + WS_SS);
    for (int row0 = gw; row0 < MT; row0 += 4 * NGW) {
        f32x4 v[4][4];
#pragma unroll
        for (int i = 0; i < 4; ++i) { const int row = min(row0 + i * NGW, MT - 1); const float* xr = row < MP ? a.in[0] + (size_t)row * DM : a.in[1] + (size_t)(row - MP) * DM;
#pragma unroll
            for (int j = 0; j < 4; ++j) v[i][j] = *(const f32x4*)(xr + (lane + 64 * j) * 4); }
        asm volatile("" : "+v"(v[0][0]), "+v"(v[0][1]), "+v"(v[0][2]), "+v"(v[0][3]), "+v"(v[1][0]), "+v"(v[1][1]), "+v"(v[1][2]), "+v"(v[1][3]),
                     "+v"(v[2][0]), "+v"(v[2][1]), "+v"(v[2][2]), "+v"(v[2][3]), "+v"(v[3][0]), "+v"(v[3][1]), "+v"(v[3][2]), "+v"(v[3][3]) :: "memory");
#pragma unroll
        for (int i = 0; i < 4; ++i) { const int row = row0 + i * NGW; if (row < MT) { float sq = 0.f;
#pragma unroll
            for (int j = 0; j < 4; ++j) { sq += (v[i][j].x * v[i][j].x + v[i][j].y * v[i][j].y) + (v[i][j].z * v[i][j].z + v[i][j].w * v[i][j].w);
                u32x2 w; w.x = pk_bf16(v[i][j].x, v[i][j].y); w.y = pk_bf16(v[i][j].z, v[i][j].w); *(u32x2*)(XB + (size_t)row * DM + (lane + 64 * j) * 4) = w; }
            sq = wave_sum(sq);
            if (lane < 16) SS[(size_t)row * 16 + lane] = lane == 0 ? sq : 0.f; } }
    }
}

__device__ __forceinline__ void f_unit(int tile, const bf16_t* XB, const bf16_t* WF, const float* SS, const float* bf, float* out) {
    const int tid = fresh_tid(), lane = tid & 63, wid = __builtin_amdgcn_readfirstlane(tid >> 6), fr = lane & 15, fq = lane >> 4;
#pragma unroll 1
    for (int mf = 0; mf < 2; ++mf) {
        const int rowb = tile * 256 + wid * 32 + mf * 16;
        const bf16_t* ap = XB + (size_t)(rowb + fr) * DM + fq * 8; const bf16_t* bp = WF + (size_t)fr * DM + fq * 8;
        f32x4 acc = (f32x4){0.f, 0.f, 0.f, 0.f};
#pragma unroll 1
        for (int kb = 0; kb < 4; ++kb) {
            bf16x8 av[8], bv[8];
#pragma unroll
            for (int uu = 0; uu < 8; ++uu) { av[uu] = *(const bf16x8*)(ap + (kb * 8 + uu) * 32); bv[uu] = *(const bf16x8*)(bp + (kb * 8 + uu) * 32); }
            asm volatile("" : "+v"(av[0]), "+v"(av[1]), "+v"(av[2]), "+v"(av[3]), "+v"(av[4]), "+v"(av[5]), "+v"(av[6]), "+v"(av[7]),
                         "+v"(bv[0]), "+v"(bv[1]), "+v"(bv[2]), "+v"(bv[3]), "+v"(bv[4]), "+v"(bv[5]), "+v"(bv[6]), "+v"(bv[7]) :: "memory");
#pragma unroll
            for (int uu = 0; uu < 8; ++uu) acc = __builtin_amdgcn_mfma_f32_16x16x32_bf16(bv[uu], av[uu], acc, 0, 0, 0);
        }
        const int row = rowb + fr;
        if (fq < 2) {
            const float rs = row_rstd(SS, row); f32x4 o;
#pragma unroll
            for (int e = 0; e < 4; ++e) { const float z = acc[e] * rs + bf[4 * fq + e]; o[e] = fminf(z, 0.f) - log1pf(__expf(-fabsf(z))); }
            float* p = row < MP ? out + OFF_FP + (size_t)row * 8 + 4 * fq : out + OFF_FS + (size_t)(row - MP) * 8 + 4 * fq;
            *(f32x4*)p = o;
        }
    }
}

constexpr int AT_C2 = 0, AT_K = 8448, AT_KB = 64 * 144, AT_VT = AT_K + 2 * AT_KB, AT_VB = 64 * 136, AT_WT = AT_VT + 2 * AT_VB;
__device__ __forceinline__ int crow(int r, int hi) { return (r & 3) + 8 * (r >> 2) + 4 * hi; }

__device__ __forceinline__ void scan2048(float v0, float v1, float v2, float v3, LAS unsigned char* lds) {
    const int tid = fresh_tid(), lane = tid & 63, wid = tid >> 6;
    LAS float* c2s = (LAS float*)(lds + AT_C2); LAS float* wt = (LAS float*)(lds + AT_WT);
    const float a0 = v0, a1 = a0 + v1, a2 = a1 + v2, a3 = a2 + v3;
    float x = a3;
#pragma unroll
    for (int off = 1; off < 64; off <<= 1) { const float y = __shfl_up(x, off); if (lane >= off) x += y; }
    if (lane == 63) wt[wid] = x;
    __syncthreads();
    float pre = x - a3;
    for (int w = 0; w < wid; ++w) pre += wt[w];
    c2s[4 * tid + 0] = (pre + a0) * LOG2E; c2s[4 * tid + 1] = (pre + a1) * LOG2E; c2s[4 * tid + 2] = (pre + a2) * LOG2E; c2s[4 * tid + 3] = (pre + a3) * LOG2E;
    __syncthreads();
}

struct AttnJob {
    const bf16_t* Qrow0;
    bf16_t* Orow0;
    int nqw, qpos0, NT, mode;
    const bf16_t* Kb;
    const float* cK; const float* cV;
};

__device__ __forceinline__ void attn_load(const AttnJob& J, int t, u32x4& kreg, u32x4& vreg) {
    const int tid = fresh_tid(), key = tid >> 3, ch = tid & 7, kidx = 64 * t + key;
    if (J.mode == 0) { const bf16_t* p = J.Kb + (size_t)kidx * 2048 + ch * 8; kreg = *(const u32x4*)p; vreg = *(const u32x4*)(p + 512); }
    else if (kidx < PAST) { const float* pk = J.cK + (size_t)kidx * 512 + ch * 8; const float* pv = J.cV + (size_t)kidx * 512 + ch * 8;
        const f32x4 a = *(const f32x4*)pk, b = *(const f32x4*)(pk + 4), c = *(const f32x4*)pv, d = *(const f32x4*)(pv + 4);
        kreg = (u32x4){pk_bf16(a.x, a.y), pk_bf16(a.z, a.w), pk_bf16(b.x, b.y), pk_bf16(b.z, b.w)};
        vreg = (u32x4){pk_bf16(c.x, c.y), pk_bf16(c.z, c.w), pk_bf16(d.x, d.y), pk_bf16(d.z, d.w)}; }
    else if (kidx < PAST + TS) { const bf16_t* p = J.Kb + (size_t)(kidx - PAST) * 2048 + ch * 8; kreg = *(const u32x4*)p; vreg = *(const u32x4*)(p + 512); }
    else { kreg = (u32x4){0u, 0u, 0u, 0u}; vreg = kreg; }
}
__device__ __forceinline__ void attn_stage(LAS unsigned char* lds, int buf, const u32x4& kreg, const u32x4& vreg) {
    const int tid = fresh_tid(), key = tid >> 3, ch = tid & 7;
    *(LAS u32x4*)(lds + AT_K + buf * AT_KB + key * 144 + ch * 16) = kreg;
    LAS bf16_t* vt = (LAS bf16_t*)(lds + AT_VT + buf * AT_VB) + (ch * 8) * 68 + key;
    vt[0 * 68] = (bf16_t)(vreg.x & 0xffffu); vt[1 * 68] = (bf16_t)(vreg.x >> 16);
    vt[2 * 68] = (bf16_t)(vreg.y & 0xffffu); vt[3 * 68] = (bf16_t)(vreg.y >> 16);
    vt[4 * 68] = (bf16_t)(vreg.z & 0xffffu); vt[5 * 68] = (bf16_t)(vreg.z >> 16);
    vt[6 * 68] = (bf16_t)(vreg.w & 0xffffu); vt[7 * 68] = (bf16_t)(vreg.w >> 16);
}

__device__ __forceinline__ void attn_tile(int t, int buf, LAS unsigned char* lds, const bf16x8 (&qr)[4], float cq2, int qlo, int qpos, int q32, int hi,
                                          float& mrun, float& lrun, f32x16& o0, f32x16& o1) {
    const LAS float* c2s = (const LAS float*)(lds + AT_C2);
    const LAS unsigned char* Kt = lds + AT_K + buf * AT_KB; const LAS unsigned char* Vt = lds + AT_VT + buf * AT_VB;
    f32x16 s0, s1;
#pragma unroll
    for (int j = 0; j < 4; ++j) {
        const f32x4 c0 = *(const LAS f32x4*)(c2s + 64 * t + 8 * j + 4 * hi), c1 = *(const LAS f32x4*)(c2s + 64 * t + 32 + 8 * j + 4 * hi);
#pragma unroll
        for (int e = 0; e < 4; ++e) { s0[4 * j + e] = cq2 - c0[e]; s1[4 * j + e] = cq2 - c1[e]; }
    }
#pragma unroll
    for (int d0 = 0; d0 < 4; ++d0) {
        const bf16x8 k0 = *(const LAS bf16x8*)(Kt + q32 * 144 + d0 * 32 + hi * 16);
        const bf16x8 k1 = *(const LAS bf16x8*)(Kt + (32 + q32) * 144 + d0 * 32 + hi * 16);
        s0 = __builtin_amdgcn_mfma_f32_32x32x16_bf16(k0, qr[d0], s0, 0, 0, 0);
        s1 = __builtin_amdgcn_mfma_f32_32x32x16_bf16(k1, qr[d0], s1, 0, 0, 0);
    }
    if (64 * t + 63 > qlo) {
#pragma unroll
        for (int r = 0; r < 16; ++r) { const int kv = 64 * t + crow(r, hi); if (kv > qpos) s0[r] = -INFINITY; if (kv + 32 > qpos) s1[r] = -INFINITY; }
    }
    float mx = fmaxf(s0[0], s1[0]);
#pragma unroll
    for (int r = 1; r < 16; ++r) mx = fmaxf(mx, fmaxf(s0[r], s1[r]));
    mx = fmaxf(mx, __shfl_xor(mx, 32));
    const float mnew = fmaxf(mrun, mx);
    if (__any(mnew > mrun)) {
        const float alpha = fexp2(mrun - mnew); lrun *= alpha;
#pragma unroll
        for (int r = 0; r < 16; ++r) { o0[r] *= alpha; o1[r] *= alpha; }
    }
    mrun = mnew;
    float ls = 0.f;
#pragma unroll
    for (int r = 0; r < 16; ++r) { s0[r] = fexp2(s0[r] - mnew); s1[r] = fexp2(s1[r] - mnew); ls += s0[r] + s1[r]; }
    lrun += ls;
#pragma unroll
    for (int p = 0; p < 2; ++p)
#pragma unroll
        for (int sx = 0; sx < 2; ++sx) {
            u32x4 pw;
            if (p == 0) pw = (u32x4){pk_bf16(s0[8 * sx + 0], s0[8 * sx + 1]), pk_bf16(s0[8 * sx + 2], s0[8 * sx + 3]), pk_bf16(s0[8 * sx + 4], s0[8 * sx + 5]), pk_bf16(s0[8 * sx + 6], s0[8 * sx + 7])};
            else        pw = (u32x4){pk_bf16(s1[8 * sx + 0], s1[8 * sx + 1]), pk_bf16(s1[8 * sx + 2], s1[8 * sx + 3]), pk_bf16(s1[8 * sx + 4], s1[8 * sx + 5]), pk_bf16(s1[8 * sx + 6], s1[8 * sx + 7])};
            const bf16x8 pf = __builtin_bit_cast(bf16x8, pw);
            const int ko = (32 * p + 16 * sx + 4 * hi) * 2;
            const u32x2 a0 = *(const LAS u32x2*)(Vt + q32 * 136 + ko), a1 = *(const LAS u32x2*)(Vt + q32 * 136 + ko + 16);
            const u32x2 b0 = *(const LAS u32x2*)(Vt + (32 + q32) * 136 + ko), b1 = *(const LAS u32x2*)(Vt + (32 + q32) * 136 + ko + 16);
            const bf16x8 vf0 = __builtin_bit_cast(bf16x8, (u32x4){a0.x, a0.y, a1.x, a1.y});
            const bf16x8 vf1 = __builtin_bit_cast(bf16x8, (u32x4){b0.x, b0.y, b1.x, b1.y});
            o0 = __builtin_amdgcn_mfma_f32_32x32x16_bf16(vf0, pf, o0, 0, 0, 0);
            o1 = __builtin_amdgcn_mfma_f32_32x32x16_bf16(vf1, pf, o1, 0, 0, 0);
        }
}

__device__ __forceinline__ void attn_unit(const AttnJob& J, LAS unsigned char* lds) {
    const int tid = fresh_tid(), lane = tid & 63, q32 = lane & 31, hi = lane >> 5; const int wid = __builtin_amdgcn_readfirstlane(tid >> 6);
    const LAS float* c2s = (const LAS float*)(lds + AT_C2);
    const bool active = wid < J.nqw;
    const int qlo = J.qpos0 + 32 * wid, qpos = qlo + q32;
    bf16x8 qr[4]; float cq2 = 0.f;
    if (active) {
#pragma unroll
        for (int d0 = 0; d0 < 4; ++d0) qr[d0] = *(const bf16x8*)(J.Qrow0 + (size_t)(32 * wid + q32) * 2048 + d0 * 16 + hi * 8);
        cq2 = c2s[qpos];
    } else {
#pragma unroll
        for (int d0 = 0; d0 < 4; ++d0) qr[d0] = (bf16x8){0, 0, 0, 0, 0, 0, 0, 0};
    }
    float mrun = -1e30f, lrun = 0.f; f32x16 o0, o1;
#pragma unroll
    for (int r = 0; r < 16; ++r) { o0[r] = 0.f; o1[r] = 0.f; }
    u32x4 kA, vA, kB, vB;
    attn_load(J, 0, kA, vA);
    if (J.NT > 1) attn_load(J, 1, kB, vB); else { kB = (u32x4){0u, 0u, 0u, 0u}; vB = kB; }
    for (int t = 0; t < J.NT; t += 2) {
        attn_stage(lds, 0, kA, vA);
        __syncthreads();
        if (t + 2 < J.NT) attn_load(J, t + 2, kA, vA);
        if (active && 64 * t <= qlo + 31) attn_tile(t, 0, lds, qr, cq2, qlo, qpos, q32, hi, mrun, lrun, o0, o1);
        if (t + 1 < J.NT) {
            attn_stage(lds, 1, kB, vB);
            __syncthreads();
            if (t + 3 < J.NT) attn_load(J, t + 3, kB, vB);
            if (active && 64 * (t + 1) <= qlo + 31) attn_tile(t + 1, 1, lds, qr, cq2, qlo, qpos, q32, hi, mrun, lrun, o0, o1);
        }
    }
    if (active) {
        const float lt = lrun + __shfl_xor(lrun, 32); const float inv = 1.0f / lt;
        bf16_t* op = J.Orow0 + (size_t)(32 * wid + q32) * DM;
#pragma unroll
        for (int j = 0; j < 4; ++j) {
            u32x2 w0, w1;
            w0.x = pk_bf16(o0[4 * j + 0] * inv, o0[4 * j + 1] * inv); w0.y = pk_bf16(o0[4 * j + 2] * inv, o0[4 * j + 3] * inv);
            w1.x = pk_bf16(o1[4 * j + 0] * inv, o1[4 * j + 1] * inv); w1.y = pk_bf16(o1[4 * j + 2] * inv, o1[4 * j + 3] * inv);
            *(u32x2*)(op + 8 * j + 4 * hi) = w0; *(u32x2*)(op + 32 + 8 * j + 4 * hi) = w1;
        }
    }
    __syncthreads();
}

__device__ __forceinline__ void pool_unit(int tile, int g, const bf16_t* QKVU, const float* state_pool, const bf16_t* POOLWT, bf16_t* MIX, LAS unsigned char* lds) {
    const int tid = fresh_tid(), lane = tid & 63, wid = __builtin_amdgcn_readfirstlane(tid >> 6), fr = lane & 15, fq = lane >> 4;
    LAS float* U = (LAS float*)lds; LAS bf16_t* Dm = (LAS bf16_t*)(lds + 96256);
    const bool samp = tile >= 512; const int r0 = tile * 128; const int t0 = r0 & 2047;
    bf16x8 wv[4][8];
#pragma unroll
    for (int ks = 0; ks < 4; ++ks)
#pragma unroll
        for (int nf = 0; nf < 8; ++nf) wv[ks][nf] = *(const bf16x8*)(POOLWT + (size_t)(g * 128 + 16 * nf + fr) * 128 + 32 * ks + 8 * fq);
    if (!samp) {
        u32x4 uw[5];
#pragma unroll
        for (int it = 0; it < 5; ++it) { const int idx = tid + 512 * it, row = idx >> 4, ch = idx & 15;
            const int grow = max(r0 - 15 + min(row, 142), 0);
            uw[it] = *(const u32x4*)(QKVU + (size_t)grow * 2048 + 1536 + g * 128 + ch * 8); }
        asm volatile("" : "+v"(uw[0]), "+v"(uw[1]), "+v"(uw[2]), "+v"(uw[3]), "+v"(uw[4]) :: "memory");
#pragma unroll
        for (int it = 0; it < 5; ++it) { const int idx = tid + 512 * it, row = idx >> 4, ch = idx & 15;
            if (idx < 143 * 16) { f32x4 lo = (f32x4){0.f, 0.f, 0.f, 0.f}, hi4 = lo; const u32x4 w = uw[it];
                if (t0 - 15 + row >= 0) { lo = (f32x4){bf_lo(w.x), bf_hi(w.x), bf_lo(w.y), bf_hi(w.y)}; hi4 = (f32x4){bf_lo(w.z), bf_hi(w.z), bf_lo(w.w), bf_hi(w.w)}; }
                *(LAS f32x4*)(U + row * 128 + ch * 8) = lo; *(LAS f32x4*)(U + row * 128 + ch * 8 + 4) = hi4; } }
    } else {
        for (int idx = tid; idx < 188 * 16; idx += 512) { const int row = idx >> 4, ch = idx & 15, sb = row / 47, rr = row - sb * 47, b = (tile - 512) * 4 + sb; f32x4 lo, hi4;
            if (rr < 15) { const float* p = state_pool + (size_t)(b * 15 + rr) * 512 + g * 128 + ch * 8; lo = *(const f32x4*)p; hi4 = *(const f32x4*)(p + 4); }
            else { const u32x4 w = *(const u32x4*)(QKVU + (size_t)(MP + b * 32 + rr - 15) * 2048 + 1536 + g * 128 + ch * 8);
                lo = (f32x4){bf_lo(w.x), bf_hi(w.x), bf_lo(w.y), bf_hi(w.y)}; hi4 = (f32x4){bf_lo(w.z), bf_hi(w.z), bf_lo(w.w), bf_hi(w.w)}; }
            *(LAS f32x4*)(U + row * 128 + ch * 8) = lo; *(LAS f32x4*)(U + row * 128 + ch * 8 + 4) = hi4; }
    }
    __syncthreads();
    {
        const int c = tid & 127, rq = tid >> 7, w = 2 << g;
        const int ubase = samp ? rq * 47 : 0, tl0 = samp ? 0 : 32 * rq, pos0 = samp ? PAST : (t0 + 32 * rq);
        const LAS float* Uc = U + (ubase + 15 + tl0) * 128 + c;
        const float invw = 1.0f / (float)w;
        float wsum = 0.f;
        for (int j = 1; j < w; ++j) wsum += Uc[-j * 128];
        for (int i = 0; i < 32; ++i) {
            const float cur = Uc[i * 128]; wsum += cur;
            const int np = pos0 + i + 1;
            const float d = wsum * (np >= w ? invw : frcp((float)np)) - cur;
            Dm[(32 * rq + i) * 136 + c] = (bf16_t)(pk_bf16(d, 0.f) & 0xffffu);
            wsum -= Uc[(i - (w - 1)) * 128];
        }
    }
    __syncthreads();
    {
        f32x4 acc[8];
#pragma unroll
        for (int nf = 0; nf < 8; ++nf) acc[nf] = (f32x4){0.f, 0.f, 0.f, 0.f};
        asm volatile("" : "+v"(wv[0][0]), "+v"(wv[0][1]), "+v"(wv[0][2]), "+v"(wv[0][3]), "+v"(wv[0][4]), "+v"(wv[0][5]), "+v"(wv[0][6]), "+v"(wv[0][7]),
                     "+v"(wv[1][0]), "+v"(wv[1][1]), "+v"(wv[1][2]), "+v"(wv[1][3]), "+v"(wv[1][4]), "+v"(wv[1][5]), "+v"(wv[1][6]), "+v"(wv[1][7]));
        asm volatile("" : "+v"(wv[2][0]), "+v"(wv[2][1]), "+v"(wv[2][2]), "+v"(wv[2][3]), "+v"(wv[2][4]), "+v"(wv[2][5]), "+v"(wv[2][6]), "+v"(wv[2][7]),
                     "+v"(wv[3][0]), "+v"(wv[3][1]), "+v"(wv[3][2]), "+v"(wv[3][3]), "+v"(wv[3][4]), "+v"(wv[3][5]), "+v"(wv[3][6]), "+v"(wv[3][7]));
#pragma unroll
        for (int ks = 0; ks < 4; ++ks) {
            const bf16x8 av = *(const LAS bf16x8*)(Dm + (16 * wid + fr) * 136 + 32 * ks + 8 * fq);
#pragma unroll
            for (int nf = 0; nf < 8; ++nf) acc[nf] = __builtin_amdgcn_mfma_f32_16x16x32_bf16(wv[ks][nf], av, acc[nf], 0, 0, 0);
        }
        const int row = r0 + 16 * wid + fr;
#pragma unroll
        for (int nf = 0; nf < 8; ++nf) { u32x2 w; w.x = pk_bf16(acc[nf][0], acc[nf][1]); w.y = pk_bf16(acc[nf][2], acc[nf][3]);
            *(u32x2*)(MIX + (size_t)row * DM + 512 + g * 128 + 16 * nf + 4 * fq) = w; }
    }
    __syncthreads();
}

__device__ __forceinline__ void sgu_unit(int chunk, int g, const bf16_t* ZUV, const float* SS2, const float* gn, const bf16_t* SGUW, const float* bs, bf16_t* MIX, LAS unsigned char* lds) {
    const int tid = fresh_tid(), lane = tid & 63, wid = __builtin_amdgcn_readfirstlane(tid >> 6), q32 = lane & 31, hi = lane >> 5;
    LAS bf16_t* ZT = (LAS bf16_t*)lds;
    const int r0 = chunk * 128;
    const int tb = wid & 3, cb0 = (wid >> 2) * 2, t = 32 * tb + q32;
    const int sr = tid & 127, qd = __builtin_amdgcn_readfirstlane(tid >> 7);
    const bf16_t* zp = ZUV + (size_t)(r0 + sr) * 2048 + 1024 + g * 128 + qd * 32;
    const bf16_t* wp = SGUW + (size_t)(g * 128 + t) * 128 + 8 * hi;
    const bf16_t* zup = ZUV + (size_t)(r0 + t) * 2048 + g * 128;
    u32x4 w[4]; f32x4 sq[4]; bf16x8 wvv[8]; u32x2 zav[4], zbv[4];
#pragma unroll
    for (int j = 0; j < 4; ++j) { w[j] = *(const u32x4*)(zp + j * 8); sq[j] = *(const f32x4*)(SS2 + (size_t)(r0 + sr) * 16 + 4 * j); }
#pragma unroll
    for (int ks = 0; ks < 8; ++ks) wvv[ks] = *(const bf16x8*)(wp + 16 * ks);
#pragma unroll
    for (int j = 0; j < 4; ++j) { zav[j] = *(const u32x2*)(zup + 32 * cb0 + 8 * j + 4 * hi); zbv[j] = *(const u32x2*)(zup + 32 * cb0 + 8 * j + 4 * hi + 32); }
    const float bt = bs[g * 128 + t];
    asm volatile("" : "+v"(w[0]), "+v"(w[1]), "+v"(w[2]), "+v"(w[3]), "+v"(sq[0]), "+v"(sq[1]), "+v"(sq[2]), "+v"(sq[3]),
                 "+v"(wvv[0]), "+v"(wvv[1]), "+v"(wvv[2]), "+v"(wvv[3]), "+v"(wvv[4]), "+v"(wvv[5]), "+v"(wvv[6]), "+v"(wvv[7]),
                 "+v"(zav[0]), "+v"(zav[1]), "+v"(zav[2]), "+v"(zav[3]), "+v"(zbv[0]), "+v"(zbv[1]), "+v"(zbv[2]), "+v"(zbv[3]) :: "memory");
    {
        const float sm = ((sq[0].x + sq[0].y) + (sq[0].z + sq[0].w)) + ((sq[1].x + sq[1].y) + (sq[1].z + sq[1].w)) + ((sq[2].x + sq[2].y) + (sq[2].z + sq[2].w)) + ((sq[3].x + sq[3].y) + (sq[3].z + sq[3].w));
        const float rs = rsqrtf(sm * (1.0f / 1024.0f) + EPS);
#pragma unroll
        for (int j = 0; j < 4; ++j) {
            const float* gp = gn + g * 128 + qd * 32 + j * 8; const f32x4 g0 = *(const f32x4*)gp, g1 = *(const f32x4*)(gp + 4);
            const float v[8] = {bf_lo(w[j].x) * rs * g0.x, bf_hi(w[j].x) * rs * g0.y, bf_lo(w[j].y) * rs * g0.z, bf_hi(w[j].y) * rs * g0.w, bf_lo(w[j].z) * rs * g1.x, bf_hi(w[j].z) * rs * g1.y, bf_lo(w[j].w) * rs * g1.z, bf_hi(w[j].w) * rs * g1.w};
            LAS bf16_t* zt = ZT + (qd * 32 + j * 8) * 136 + sr;
#pragma unroll
            for (int e = 0; e < 8; ++e) zt[e * 136] = (bf16_t)(pk_bf16(v[e], 0.f) & 0xffffu);
        }
    }
    __syncthreads();
    f32x16 d0, d1;
#pragma unroll
    for (int r = 0; r < 16; ++r) { d0[r] = 0.f; d1[r] = 0.f; }
#pragma unroll
    for (int ks = 0; ks < 8; ++ks) {
        const bf16x8 z0 = *(const LAS bf16x8*)(ZT + (32 * cb0 + q32) * 136 + 16 * ks + 8 * hi);
        const bf16x8 z1 = *(const LAS bf16x8*)(ZT + (32 * (cb0 + 1) + q32) * 136 + 16 * ks + 8 * hi);
        d0 = __builtin_amdgcn_mfma_f32_32x32x16_bf16(z0, wvv[ks], d0, 0, 0, 0);
        d1 = __builtin_amdgcn_mfma_f32_32x32x16_bf16(z1, wvv[ks], d1, 0, 0, 0);
    }
    bf16_t* op = MIX + (size_t)(r0 + t) * DM + g * 128;
#pragma unroll
    for (int j = 0; j < 4; ++j) {
        const int c0 = 32 * cb0 + 8 * j + 4 * hi, c1 = c0 + 32;
        const u32x2 za = zav[j], zb = zbv[j];
        u32x2 wa, wb;
        wa.x = pk_bf16(bf_lo(za.x) * (d0[4 * j + 0] + bt), bf_hi(za.x) * (d0[4 * j + 1] + bt)); wa.y = pk_bf16(bf_lo(za.y) * (d0[4 * j + 2] + bt), bf_hi(za.y) * (d0[4 * j + 3] + bt));
        wb.x = pk_bf16(bf_lo(zb.x) * (d1[4 * j + 0] + bt), bf_hi(zb.x) * (d1[4 * j + 1] + bt)); wb.y = pk_bf16(bf_lo(zb.y) * (d1[4 * j + 2] + bt), bf_hi(zb.y) * (d1[4 * j + 3] + bt));
        *(u32x2*)(op + c0) = wa; *(u32x2*)(op + c1) = wb;
    }
    __syncthreads();
}
__device__ __forceinline__ void sgu_sample_unit(int b, int g, const bf16_t* ZUV, const float* SS2, const float* gn, const float* ws_f32, const float* bs, bf16_t* MIX, float* zs_out, LAS unsigned char* lds) {
    const int tid = fresh_tid();
    LAS float* Z = (LAS float*)lds; LAS float* rsl = (LAS float*)(lds + 16384);
    const int R0 = MP + b * 32;
    if (tid < 32) rsl[tid] = row_rstd(SS2, R0 + tid);
    __syncthreads();
    { const int s = tid >> 4, ch = tid & 15; const float rs = rsl[s];
      const u32x4 w = *(const u32x4*)(ZUV + (size_t)(R0 + s) * 2048 + 1024 + g * 128 + ch * 8);
      const f32x4 g0 = *(const f32x4*)(gn + g * 128 + ch * 8), g1 = *(const f32x4*)(gn + g * 128 + ch * 8 + 4);
      const f32x4 lo = (f32x4){bf_lo(w.x) * rs * g0.x, bf_hi(w.x) * rs * g0.y, bf_lo(w.y) * rs * g0.z, bf_hi(w.y) * rs * g0.w};
      const f32x4 hi4 = (f32x4){bf_lo(w.z) * rs * g1.x, bf_hi(w.z) * rs * g1.y, bf_lo(w.w) * rs * g1.z, bf_hi(w.w) * rs * g1.w};
      *(LAS f32x4*)(Z + s * 128 + ch * 8) = lo; *(LAS f32x4*)(Z + s * 128 + ch * 8 + 4) = hi4;
      float* zo = zs_out + (size_t)(b * 32 + s) * 1024 + g * 128 + ch * 8; *(f32x4*)zo = lo; *(f32x4*)(zo + 4) = hi4; }
    __syncthreads();
    { const int c = tid & 127, tq = tid >> 7;
      for (int ti = 0; ti < 8; ++ti) { const int t = tq * 8 + ti; float acc = bs[g * 128 + t]; const float* wrow = ws_f32 + (size_t)(g * 128 + t) * 128;
#pragma unroll 8
          for (int s = 0; s < 32; ++s) acc += wrow[s] * Z[s * 128 + c];
          const float zu = bf_lo((unsigned)ZUV[(size_t)(R0 + t) * 2048 + g * 128 + c]);
          MIX[(size_t)(R0 + t) * DM + g * 128 + c] = (bf16_t)(pk_bf16(zu * acc, 0.f) & 0xffffu); } }
    __syncthreads();
}

__device__ __forceinline__ void sres_phase(const bf16_t* A, const bf16_t* Bt, int K, const float* baseS, bf16_t* XB, float* SS, float alpha, int f32base, LAS unsigned char* lds) {
    const int tid = fresh_tid(), lane = tid & 63, wid = __builtin_amdgcn_readfirstlane(tid >> 6), fr = lane & 15, fq = lane >> 4;
    const int kh = wid >> 2, w4 = wid & 3, Kh = K >> 1;
    for (int blk = blockIdx.x; blk < 256; blk += gridDim.x) {
        const int cg = blk & 15, rs = ((blk >> 4) << 2) + w4;
        const int row = MP + rs * 16 + fr;
        const bf16_t* ap = A + (size_t)row * K + kh * Kh + fq * 8;
        const bf16_t* bp = Bt + (size_t)(cg * 64 + fr) * K + kh * Kh + fq * 8;
        f32x4 acc[4];
#pragma unroll
        for (int nf = 0; nf < 4; ++nf) acc[nf] = (f32x4){0.f, 0.f, 0.f, 0.f};
#pragma unroll 1
        for (int k0 = 0; k0 < Kh; k0 += 128) {
            bf16x8 av[4], bv[4][4];
#pragma unroll
            for (int uu = 0; uu < 4; ++uu) { av[uu] = *(const bf16x8*)(ap + k0 + uu * 32);
#pragma unroll
                for (int nf = 0; nf < 4; ++nf) bv[uu][nf] = *(const bf16x8*)(bp + (size_t)nf * 16 * K + k0 + uu * 32); }
            asm volatile("" : "+v"(av[0]), "+v"(av[1]), "+v"(av[2]), "+v"(av[3]),
                         "+v"(bv[0][0]), "+v"(bv[0][1]), "+v"(bv[0][2]), "+v"(bv[0][3]), "+v"(bv[1][0]), "+v"(bv[1][1]), "+v"(bv[1][2]), "+v"(bv[1][3]),
                         "+v"(bv[2][0]), "+v"(bv[2][1]), "+v"(bv[2][2]), "+v"(bv[2][3]), "+v"(bv[3][0]), "+v"(bv[3][1]), "+v"(bv[3][2]), "+v"(bv[3][3]) :: "memory");
#pragma unroll
            for (int uu = 0; uu < 4; ++uu)
#pragma unroll
                for (int nf = 0; nf < 4; ++nf) acc[nf] = __builtin_amdgcn_mfma_f32_16x16x32_bf16(bv[uu][nf], av[uu], acc[nf], 0, 0, 0);
        }
        LAS f32x4* red = (LAS f32x4*)lds + (w4 * 4) * 64 + lane;
        if (kh == 1) {
#pragma unroll
            for (int nf = 0; nf < 4; ++nf) red[nf * 64] = acc[nf];
        }
        __syncthreads();
        if (kh == 0) {
            float ss = 0.f;
#pragma unroll
            for (int nf = 0; nf < 4; ++nf) {
                const f32x4 a2 = acc[nf] + red[nf * 64];
                const int col = cg * 64 + nf * 16 + 4 * fq; bf16_t* xp = XB + (size_t)row * DM + col; f32x4 b;
                if (f32base) b = *(const f32x4*)(baseS + (size_t)(row - MP) * DM + col);
                else { const u32x2 w = *(const u32x2*)xp; b = (f32x4){bf_lo(w.x), bf_hi(w.x), bf_lo(w.y), bf_hi(w.y)}; }
                const f32x4 x = b + a2 * alpha;
                u32x2 w; w.x = pk_bf16(x[0], x[1]); w.y = pk_bf16(x[2], x[3]); *(u32x2*)xp = w;
                ss += (x[0] * x[0] + x[1] * x[1]) + (x[2] * x[2] + x[3] * x[3]);
            }
            ss += __shfl_xor(ss, 16); ss += __shfl_xor(ss, 32);
            if (fq == 0) SS[(size_t)row * 16 + cg] = ss;
        }
        __syncthreads();
    }
}

#define XB_TMO      128
#define XB_XCNT(j)  (256  + 64 * (j))
#define XB_XSUB(j)  (1280 + 64 * (j))
#define XB_XGEN(j)  (2304 + 64 * (j))
#define XB_TOP      3328
#define XB_TOPGEN   3392
#define XCD_BAR_WORDS 3456
#define XB_SPIN_CAP (1u << 22)
__device__ __forceinline__ unsigned xb_ld(unsigned* p)              { return __hip_atomic_load(p, __ATOMIC_RELAXED, __HIP_MEMORY_SCOPE_AGENT); }
__device__ __forceinline__ unsigned xb_add(unsigned* p, unsigned v) { return __hip_atomic_fetch_add(p, v, __ATOMIC_RELAXED, __HIP_MEMORY_SCOPE_AGENT); }
__device__ __forceinline__ unsigned xb_xcc_id() { return (unsigned)__builtin_amdgcn_s_getreg((3 << 11) | 20) & 0xFu; }
#define XB_SPIN(cond, bar) do { unsigned _sp = 0; while (cond) { __builtin_amdgcn_s_sleep(1); \
    if ((++_sp & 255u) == 0u) { if (xb_ld(&(bar)[XB_TMO])) break; if (_sp > XB_SPIN_CAP) { atomicAdd(&(bar)[XB_TMO], 1u); break; } } } } while (0)
constexpr int LDS_XB = LDS_BYTES - 64;
__device__ __forceinline__ void xcd_barrier_complete(unsigned* bar, unsigned x, unsigned& nloc, unsigned& nx) {
    const unsigned G = gridDim.x * gridDim.y * gridDim.z;
    unsigned sum, cnt, mine, sp = 0u;
    for (;;) {
        sum = 0u; cnt = 0u; mine = 0u;
#pragma unroll
        for (unsigned j = 0; j < 16; ++j) { const unsigned c = xb_ld(&bar[XB_XCNT(j)]); sum += c; cnt += (c > 0u) ? 1u : 0u; mine = (j == x) ? c : mine; }
        if (sum == G) break;
        __builtin_amdgcn_s_sleep(1);
        if ((++sp & 255u) == 0u) { if (xb_ld(&bar[XB_TMO])) break; if (sp > XB_SPIN_CAP) { atomicAdd(&bar[XB_TMO], 1u); break; } }
    }
    nloc = mine > 0u ? mine : 1u; nx = cnt > 0u ? cnt : 1u;
}
__device__ __forceinline__ void gsync(unsigned* bar, LAS unsigned char* lds) {
    asm volatile("s_waitcnt vmcnt(0) lgkmcnt(0)" ::: "memory");
    __syncthreads();
    if (threadIdx.x == 0) {
        volatile LAS unsigned* st = (volatile LAS unsigned*)(lds + LDS_XB);
        __builtin_amdgcn_s_waitcnt(0);
        unsigned nloc = st[0], nx = st[1]; const unsigned x = st[2];
        if (nloc == 0u) { xcd_barrier_complete(bar, x, nloc, nx); st[0] = nloc; st[1] = nx; }
        const unsigned old = xb_add(&bar[XB_XSUB(x)], 1u);
        const unsigned gen = old / nloc;
        if (old + 1u == (gen + 1u) * nloc) {
            __builtin_amdgcn_fence(__ATOMIC_RELEASE, "agent");
            asm volatile("s_waitcnt vmcnt(0)" ::: "memory");
            const unsigned og = xb_add(&bar[XB_TOP], 1u);
            const unsigned tg = og / nx;
            if (og + 1u == (tg + 1u) * nx) xb_add(&bar[XB_TOPGEN], 1u);
            else XB_SPIN(xb_ld(&bar[XB_TOPGEN]) == tg, bar);
            __builtin_amdgcn_fence(__ATOMIC_ACQUIRE, "agent");
            xb_add(&bar[XB_XGEN(x)], 1u);
            asm volatile("s_waitcnt vmcnt(0)" ::: "memory");
        } else {
            XB_SPIN(xb_ld(&bar[XB_XGEN(x)]) == gen, bar);
            __builtin_amdgcn_fence(__ATOMIC_ACQUIRE, "agent");
            asm volatile("s_waitcnt vmcnt(0)" ::: "memory");
        }
    }
    __syncthreads();
}

__global__ void __launch_bounds__(512) fwd_megakernel(Args a) {
    extern __shared__ __attribute__((aligned(16))) unsigned char lds_raw[];
    LAS unsigned char* lds = (LAS unsigned char*)lds_raw;
    cg::grid_group grid = cg::this_grid();
    const int G = gridDim.x, bx = blockIdx.x;
    unsigned char* ws = a.ws; float* out = a.out;
    bf16_t* W1 = (bf16_t*)(ws + WS_W1); bf16_t* W2 = (bf16_t*)(ws + WS_W2);
    bf16_t* XB = (bf16_t*)(ws + WS_XB); bf16_t* MIX = (bf16_t*)(ws + WS_MIX); bf16_t* R1 = (bf16_t*)(ws + WS_R1);
    float* SS = (float*)(ws + WS_SS); float* SS2 = (float*)(ws + WS_SS2);
    float* X = out + OFF_Y;

    unsigned* bar = (unsigned*)(ws + WS_BAR);
    if (threadIdx.x == 0) { volatile LAS unsigned* st = (volatile LAS unsigned*)(lds + LDS_XB); const unsigned x = xb_xcc_id(); st[0] = 0u; st[1] = 0u; st[2] = x; (void)xb_add(&bar[XB_XCNT(x)], 1u); }
    grid.sync();
    p0_phase(a, lds);
    gsync(bar, lds);

    for (int s = 0; s < 4; ++s) {
        const int l = s >> 1, j = s & 1;
        if (j == 1) {
            if (l == 0) {
                { pg8::Gemm g{XB, (const bf16_t*)(ws + WS_WEIN), MT, 2048, DM}; pg8::StaticOrder S; S.init(MT, 2048, G, bx);
                  pg8::EpiProjEven E{R1, SS, out};
                  pg8::gemm_phase<pg8::EpiProjEven, pg8::StaticOrder, true, true>(lds, g, S, E); }
                for (int i = (G == 256 ? bx - 32 : bx + G); i >= 0 && i < MT / 256; i += (G == 256 ? 224 : G)) f_unit(i, XB, (const bf16_t*)(ws + WS_WF), SS, a.in[10], out);
                gsync(bar, lds);
                for (int bh = bx; bh < 256; bh += G) {
                    const int b = bh >> 3, h = bh & 7;
                    { const float* lf = out + OFF_FP + (size_t)b * SEQ * 8 + h; const int t = 4 * fresh_tid();
                      scan2048(lf[(size_t)(t + 0) * 8], lf[(size_t)(t + 1) * 8], lf[(size_t)(t + 2) * 8], lf[(size_t)(t + 3) * 8], lds); }
                    for (int qb = 7; qb >= 0; --qb) {
                        AttnJob J; J.Qrow0 = R1 + (size_t)(b * SEQ + qb * 256) * 2048 + h * 64; J.Orow0 = MIX + (size_t)(b * SEQ + qb * 256) * DM + h * 64;
                        J.nqw = 8; J.qpos0 = qb * 256; J.NT = 4 * (qb + 1); J.mode = 0; J.Kb = R1 + (size_t)(b * SEQ) * 2048 + 512 + h * 64; J.cK = nullptr; J.cV = nullptr;
                        attn_unit(J, lds);
                    }
                }
                for (int bh = bx; bh < 256; bh += G) {
                    const int b = bh >> 3, h = bh & 7;
                    { const float* cf = a.in[4] + (size_t)b * PAST * 8 + h; const float* nf = out + OFF_FS + (size_t)b * TS * 8 + h; float v[4]; const int tid = fresh_tid();
#pragma unroll
                      for (int e = 0; e < 4; ++e) { const int t = 4 * tid + e; v[e] = t < PAST ? cf[(size_t)t * 8] : (t < PAST + TS ? nf[(size_t)(t - PAST) * 8] : 0.f); }
                      scan2048(v[0], v[1], v[2], v[3], lds); }
                    AttnJob J; J.Qrow0 = R1 + (size_t)(MP + b * TS) * 2048 + h * 64; J.Orow0 = MIX + (size_t)(MP + b * TS) * DM + h * 64;
                    J.nqw = 1; J.qpos0 = PAST; J.NT = 17; J.mode = 1; J.Kb = R1 + (size_t)(MP + b * TS) * 2048 + 512 + h * 64;
                    J.cK = a.in[2] + (size_t)b * PAST * 512 + h * 64; J.cV = a.in[3] + (size_t)b * PAST * 512 + h * 64;
                    attn_unit(J, lds);
                }
                for (int u = bx; u < 520 * 4; u += G) pool_unit(u >> 2, u & 3, R1, a.in[5], (const bf16_t*)(ws + WS_POOLWT), MIX, lds);
                gsync(bar, lds);
                { pg8::Gemm g{MIX, (const bf16_t*)(ws + WS_WEOUT), MP, DM, DM}; pg8::StaticOrder S; S.init(MP, DM, G, bx);
                  pg8::EpiResidual E{nullptr, nullptr, XB, SS, 1.0f, 0};
                  pg8::gemm_phase<pg8::EpiResidual, pg8::StaticOrder, true, true>(lds, g, S, E); }
                sres_phase(MIX, (const bf16_t*)(ws + WS_WEOUT), DM, nullptr, XB, SS, 1.0f, 0, lds);
                gsync(bar, lds);
            } else {
                { pg8::Gemm g{XB, (const bf16_t*)(ws + WS_WSIN), MT, 2048, DM}; pg8::StaticOrder S; S.init(MT, 2048, G, bx);
                  pg8::EpiSguProj E{R1, SS, SS2};
                  pg8::gemm_phase<pg8::EpiSguProj, pg8::StaticOrder, true, true>(lds, g, S, E); }
                gsync(bar, lds);
                for (int u = bx; u < 512 * 8; u += G) sgu_unit(u >> 3, u & 7, R1, SS2, a.in[15], (const bf16_t*)(ws + WS_SGUW), a.in[17], MIX, lds);
                for (int u = bx; u < 32 * 8; u += G) sgu_sample_unit(u >> 3, u & 7, R1, SS2, a.in[15], a.in[16], a.in[17], MIX, out + OFF_ZS, lds);
                gsync(bar, lds);
                { pg8::Gemm g{MIX, (const bf16_t*)(ws + WS_WSOUT), MP, DM, DM}; pg8::StaticOrder S; S.init(MP, DM, G, bx);
                  pg8::EpiResidual E{nullptr, nullptr, XB, SS, 1.0f, 0};
                  pg8::gemm_phase<pg8::EpiResidual, pg8::StaticOrder, true, true>(lds, g, S, E); }
                sres_phase(MIX, (const bf16_t*)(ws + WS_WSOUT), DM, nullptr, XB, SS, 1.0f, 0, lds);
                gsync(bar, lds);
            }
        }
        { pg8::Gemm g{XB, W1 + (size_t)s * NFF * DM, MT, NFF, DM}; pg8::StaticOrder S; S.init(MT, NFF, G, bx);
          pg8::EpiSwiGLU E{R1, SS};
          pg8::gemm_phase<pg8::EpiSwiGLU, pg8::StaticOrder, true, true>(lds, g, S, E); }
        gsync(bar, lds);
        { pg8::Gemm g{R1, W2 + (size_t)s * DM * DFF, MP, DM, DFF}; pg8::StaticOrder S; S.init(MP, DM, G, bx);
          pg8::EpiResidual E{a.in[0], a.in[1], XB, SS, 0.5f, s == 0 ? 1 : 0};
          pg8::gemm_phase<pg8::EpiResidual, pg8::StaticOrder, true, true>(lds, g, S, E); }
        sres_phase(R1, W2 + (size_t)s * DM * DFF, DFF, a.in[1], XB, SS, 0.5f, s == 0 ? 1 : 0, lds);
        gsync(bar, lds);
    }
    {
        const int tid = fresh_tid(), lane = tid & 63, wid = __builtin_amdgcn_readfirstlane(tid >> 6);
        const int gw = bx * 8 + wid, NGW = G * 8; const float* fg = a.in[19];
        f32x4 gv[4];
#pragma unroll
        for (int jx = 0; jx < 4; ++jx) gv[jx] = *(const f32x4*)(fg + (lane + 64 * jx) * 4);
        for (int row0 = gw; row0 < MT; row0 += 4 * NGW) {
            u32x2 w[4][4];
#pragma unroll
            for (int i = 0; i < 4; ++i) { const int row = min(row0 + i * NGW, MT - 1);
#pragma unroll
                for (int jx = 0; jx < 4; ++jx) w[i][jx] = *(const u32x2*)(XB + (size_t)row * DM + (lane + 64 * jx) * 4); }
            asm volatile("" : "+v"(w[0][0]), "+v"(w[0][1]), "+v"(w[0][2]), "+v"(w[0][3]), "+v"(w[1][0]), "+v"(w[1][1]), "+v"(w[1][2]), "+v"(w[1][3]),
                         "+v"(w[2][0]), "+v"(w[2][1]), "+v"(w[2][2]), "+v"(w[2][3]), "+v"(w[3][0]), "+v"(w[3][1]), "+v"(w[3][2]), "+v"(w[3][3]) :: "memory");
#pragma unroll
            for (int i = 0; i < 4; ++i) { const int row = row0 + i * NGW; if (row < MT) { f32x4 v[4]; float ss = 0.f;
#pragma unroll
                for (int jx = 0; jx < 4; ++jx) { v[jx] = (f32x4){bf_lo(w[i][jx].x), bf_hi(w[i][jx].x), bf_lo(w[i][jx].y), bf_hi(w[i][jx].y)};
                    ss += (v[jx].x * v[jx].x + v[jx].y * v[jx].y) + (v[jx].z * v[jx].z + v[jx].w * v[jx].w); }
                ss = wave_sum(ss); const float r = rsqrtf(ss * (1.0f / 1024.0f) + EPS); float* yr = X + (size_t)row * DM;
#pragma unroll
                for (int jx = 0; jx < 4; ++jx) *(f32x4*)(yr + (lane + 64 * jx) * 4) = v[jx] * r * gv[jx]; } }
        }
    }
}

extern "C" void kernel_launch(void* const* d_in, const int* in_sizes, int n_in, void* d_out, int out_size, void* d_ws, size_t ws_size, hipStream_t stream) {
    static int grid = 0;
    if (grid == 0) {
        if (n_in != 20 || ws_size < WS_END) { fprintf(stderr, "kernel_launch: unexpected inputs (n_in %d, ws %zu, need %zu)\n", n_in, ws_size, (size_t)WS_END); grid = -1; return; }
        int dev = 0, cus = 0, per_cu = 0;
        hipGetDevice(&dev);
        hipDeviceGetAttribute(&cus, hipDeviceAttributeMultiprocessorCount, dev);
        if (hipFuncSetAttribute((const void*)fwd_megakernel, hipFuncAttributeMaxDynamicSharedMemorySize, LDS_BYTES) != hipSuccess) { fprintf(stderr, "kernel_launch: hipFuncSetAttribute failed\n"); grid = -1; return; }
        if (hipOccupancyMaxActiveBlocksPerMultiprocessor(&per_cu, (const void*)fwd_megakernel, 512, LDS_BYTES) != hipSuccess || per_cu < 1) { fprintf(stderr, "kernel_launch: occupancy query gives %d\n", per_cu); per_cu = 1; }
        (void)hipGetLastError();
        grid = cus * per_cu;
    }
    if (grid < 0) return;
    if (hipMemsetAsync((char*)d_ws + WS_BAR, 0, 16384, stream) != hipSuccess) { fprintf(stderr, "kernel_launch: memset failed\n"); return; }
    Args a{};
    for (int i = 0; i < 20; ++i) a.in[i] = (const float*)d_in[i];
    a.out = (float*)d_out; a.ws = (unsigned char*)d_ws;
    void* args[] = {&a};
    hipError_t e = hipLaunchCooperativeKernel((const void*)fwd_megakernel, dim3(grid), dim3(512), args, LDS_BYTES, stream);
    if (e != hipSuccess) fprintf(stderr, "cooperative launch failed: %s (grid %d)\n", hipGetErrorString(e), grid);
}
```

```cpp
#include <hip/hip_runtime.h>
#include <hip/hip_cooperative_groups.h>
#include <cstdio>
#include <cstdint>
namespace cg = cooperative_groups;

#define LAS __attribute__((address_space(3)))
typedef unsigned short bf16_t;
typedef short bf16x8 __attribute__((ext_vector_type(8)));
typedef float f32x4 __attribute__((ext_vector_type(4)));
typedef float f32x16 __attribute__((ext_vector_type(16)));
typedef unsigned u32x4 __attribute__((ext_vector_type(4)));
typedef unsigned u32x2 __attribute__((ext_vector_type(2)));

constexpr int DM = 1024, MP = 65536, MS = 1024, MT = MP + MS, DFF = 2816, NFF = 5632;
constexpr int SEQ = 2048, TS = 32, PAST = 1024;
constexpr float EPS = 1e-6f, LOG2E = 1.4426950408889634f, QSCALE = 0.125f * 1.4426950408889634f;
constexpr size_t OFF_Y = 0, OFF_KP = 68157440, OFF_VP = 101711872, OFF_FP = 135266304, OFF_PP = 135790592,
                 OFF_KS = 136036352, OFF_VS = 136560640, OFF_FS = 137084928, OFF_PS = 137093120, OFF_ZS = 137338880;
constexpr size_t WS_W1 = 0;
constexpr size_t WS_W2 = WS_W1 + (size_t)4 * NFF * DM * 2;
constexpr size_t WS_WEIN = WS_W2 + (size_t)4 * DM * DFF * 2;
constexpr size_t WS_WF = WS_WEIN + (size_t)2048 * DM * 2;
constexpr size_t WS_WEOUT = WS_WF + (size_t)16 * DM * 2;
constexpr size_t WS_WSIN = WS_WEOUT + (size_t)DM * DM * 2;
constexpr size_t WS_WSOUT = WS_WSIN + (size_t)2048 * DM * 2;
constexpr size_t WS_POOLWT = WS_WSOUT + (size_t)DM * DM * 2;
constexpr size_t WS_SGUW = WS_POOLWT + (size_t)4 * 128 * 128 * 2;
constexpr size_t WS_SS = WS_SGUW + (size_t)8 * 128 * 128 * 2;
constexpr size_t WS_SS2 = WS_SS + (size_t)MT * 16 * 4;
constexpr size_t WS_XB = WS_SS2 + (size_t)MT * 16 * 4;
constexpr size_t WS_MIX = WS_XB + (size_t)MT * DM * 2;
constexpr size_t WS_R1 = WS_MIX + (size_t)MT * DM * 2;
constexpr size_t WS_BAR = WS_R1 + (size_t)MT * DFF * 2;
constexpr size_t WS_END = WS_BAR + 16384;
constexpr int LDS_BYTES = 147456;

struct Args {
    const float* in[20];
    float* out;
    unsigned char* ws;
};

typedef float f32x2_t __attribute__((ext_vector_type(2))); typedef __bf16 bf16x2_t __attribute__((ext_vector_type(2)));
__device__ __forceinline__ unsigned pk_bf16(float lo, float hi) { const f32x2_t v = {lo, hi}; const bf16x2_t b = __builtin_convertvector(v, bf16x2_t); return __builtin_bit_cast(unsigned, b); }
__device__ __forceinline__ int fresh_tid() { int t = threadIdx.x; asm volatile("" : "+v"(t)); return t; }
__device__ __forceinline__ float bf_lo(unsigned w) { return __uint_as_float(w << 16); }
__device__ __forceinline__ float bf_hi(unsigned w) { return __uint_as_float(w & 0xffff0000u); }
__device__ __forceinline__ float fexp2(float x) { return __builtin_amdgcn_exp2f(x); }
__device__ __forceinline__ float frcp(float x) { return __builtin_amdgcn_rcpf(x); }
__device__ __forceinline__ float wave_sum(float v) {
#pragma unroll
    for (int o = 1; o < 64; o <<= 1) v += __shfl_xor(v, o);
    return v;
}
__device__ __forceinline__ float row_rstd(const float* SS, int row) {
    const f32x4* p = (const f32x4*)(SS + (size_t)row * 16);
    const f32x4 a = p[0], b = p[1], c = p[2], d = p[3];
    const float s = ((a.x + a.y) + (a.z + a.w)) + ((b.x + b.y) + (b.z + b.w)) + ((c.x + c.y) + (c.z + c.w)) + ((d.x + d.y) + (d.z + d.w));
    return rsqrtf(s * (1.0f / 1024.0f) + EPS);
}
typedef float f32x2 __attribute__((ext_vector_type(2)));
__device__ __forceinline__ f32x2 swiglu2(f32x2 g, f32x2 u, float k1, float rs2) {
    const f32x2 a = g * k1; f32x2 e; e.x = fexp2(a.x); e.y = fexp2(a.y);
    const f32x2 d = e + 1.0f; f32x2 r; r.x = frcp(d.x); r.y = frcp(d.y);
    return (g * u) * (r * rs2);
}
__device__ __forceinline__ f32x2 gelu2(f32x2 x) {
    const f32x2 p = (x * x) * 0.044715f + 1.0f; const f32x2 a = (x * p) * (-LOG2E * 1.5957691216057308f);
    f32x2 e; e.x = fexp2(a.x); e.y = fexp2(a.y); const f32x2 d = e + 1.0f; f32x2 r; r.x = frcp(d.x); r.y = frcp(d.y);
    return x * r;
}
__device__ __forceinline__ float silu_mul(float g, float u) { return g * frcp(1.0f + fexp2(-LOG2E * g)) * u; }
__device__ __forceinline__ float gelu_tanh(float x) { const float t = x + 0.044715f * x * x * x; return x * frcp(1.0f + fexp2(-LOG2E * 1.5957691216057308f * t)); }

namespace pg8 {
#define PG8_LAS __attribute__((address_space(3)))
constexpr int BM = 256, BK = 64, HALF = 128, HTB = HALF * BK * 2, STAGE_BYTES = 8 * HTB, NXCD = 8, WGM = 8;
__host__ __device__ __forceinline__ int lds_byte(int r, int c) { const int st = (r >> 4) * 2 + (c >> 5), rr = r & 15, cc = c & 31, ob = rr * 64 + cc * 2; return st * 1024 + (ob ^ (((ob >> 9) & 1) << 5)); }
__host__ __device__ __forceinline__ void stage_rc(int b, int& R, int& C) { const int st = b / 1024, sb = b % 1024, swz = sb ^ (((sb >> 9) & 1) << 5); R = (st >> 1) * 16 + swz / 64; C = (st & 1) * 32 + (swz % 64) / 2; }
__host__ __device__ __forceinline__ int perm32(int rho) { const int n = rho >> 4, i = rho & 15; return 8 * (i >> 2) + 4 * n + (i & 3); }
struct Unit { int pm, pn; };
struct Gemm { const bf16_t* A; const bf16_t* Bt; int M, N, K; };
struct StaticOrder {
    int nM, nN, nwg, G, c, rev;
    __host__ __device__ void init(int M, int N, int G_, int c_) { nM = M / BM; nN = N / BM; nwg = nM * nN; G = G_; c = c_; rev = 0; }
    __host__ __device__ bool next(int i, Unit& u) const {
        const long L = (long)i * G + c; if (L >= nwg) return false;
        int wgid = (int)L; { const int q = nwg / NXCD, r = nwg % NXCD, xcd = wgid % NXCD, off = wgid / NXCD; wgid = (xcd < r ? xcd * (q + 1) : r * (q + 1) + (xcd - r) * q) + off; }
        const int nig = WGM * nN, gid = wgid / nig, fm = gid * WGM, gsz = (nM - fm) < WGM ? (nM - fm) : WGM;
        u.pm = fm + ((wgid % nig) % gsz); u.pn = (wgid % nig) / gsz; if (rev) u.pm = nM - 1 - u.pm; return true;
    }
    __device__ __forceinline__ void a_ready(const Unit&) const {}
    __device__ __forceinline__ void done(const Unit&) const {}
};
template <class Epi, class Sched, bool ALIGN_EPI = false, bool SP2 = false>
__device__ __forceinline__ void gemm_phase(PG8_LAS unsigned char* lds, const Gemm g, const Sched& S, const Epi& E) {
    const int tid = fresh_tid(), wid = __builtin_amdgcn_readfirstlane(tid >> 6), lane = tid & 63, wr = wid >> 2, wc = wid & 3, fr = lane & 15, fq = lane >> 4;
    const int K = g.K, nt = K / BK;
    unsigned voffA[2], voffB[2];
#pragma unroll
    for (int i = 0; i < 2; ++i) { int R, C; stage_rc(tid * 16 + i * 8192, R, C); const int Rb = Epi::PERM ? ((R & ~31) + perm32(R & 31)) : R;
        voffA[i] = (unsigned)(R * K + C) * 2u; voffB[i] = (unsigned)(Rb * K + C) * 2u; }
    const size_t kstep = (size_t)(BK * 2);
    const size_t hstep = (size_t)HALF * K * 2;
    const size_t tstep = 2 * hstep;
    const unsigned ldsw = (unsigned)wid * 1024u;
    const int aoff = lds_byte(wr * 64 + fr, fq * 8), boff = lds_byte(wc * 32 + fr, fq * 8);
#define PG8_SA(b, h) (((b) * 2 + (h)) * HTB)
#define PG8_SB(b, h) ((4 + (b) * 2 + (h)) * HTB)
#define PG8_STAGE(bufoff, gbase, voff) do { _Pragma("unroll") for (int _i = 0; _i < 2; ++_i) \
        __builtin_amdgcn_global_load_lds((const unsigned*)((const char*)(gbase) + (voff)[_i]), (PG8_LAS unsigned*)(lds + (bufoff) + ldsw + _i * 8192), 16, 0, 0); } while (0)
#define PG8_LDA(dst, b, h) do { _Pragma("unroll") for (int m = 0; m < 4; ++m) _Pragma("unroll") for (int k = 0; k < 2; ++k) dst[m][k] = *(const PG8_LAS bf16x8*)(lds + PG8_SA(b, h) + aoff + m * 2048 + k * 1024); } while (0)
#define PG8_LDB(dst, b, h) do { _Pragma("unroll") for (int n = 0; n < 2; ++n) _Pragma("unroll") for (int k = 0; k < 2; ++k) dst[n][k] = *(const PG8_LAS bf16x8*)(lds + PG8_SB(b, h) + boff + n * 2048 + k * 1024); } while (0)
#define PG8_MMA(ai, bj, At, Bt) do { __builtin_amdgcn_s_setprio(1); _Pragma("unroll") for (int m = 0; m < 4; ++m) _Pragma("unroll") for (int n = 0; n < 2; ++n) _Pragma("unroll") for (int k = 0; k < 2; ++k) \
        acc[ai][bj][m][n] = __builtin_amdgcn_mfma_f32_16x16x32_bf16(Bt[n][k], At[m][k], acc[ai][bj][m][n], 0, 0, 0); __builtin_amdgcn_s_setprio(0); } while (0)
#define PG8_WAIT_V(n) asm volatile("s_waitcnt vmcnt(" #n ")" ::: "memory")
#define PG8_WAIT_L(n) asm volatile("s_waitcnt lgkmcnt(" #n ")" ::: "memory")
#define PG8_BAR __builtin_amdgcn_s_barrier()
#define PG8_SCHED __builtin_amdgcn_sched_barrier(0)
    PG8_LAS float* rsl = (PG8_LAS float*)(lds + STAGE_BYTES);
    f32x4 rq0, rq1, rq2, rq3;
#define PG8_RS_ISSUE(U) do { if (Epi::RS && tid < 256) { const f32x4* _p = (const f32x4*)(E.SS + (size_t)((U).pm * BM + tid) * 16); rq0 = _p[0]; rq1 = _p[1]; rq2 = _p[2]; rq3 = _p[3]; } } while (0)
#define PG8_RS_COMMIT(PAR) do { if (Epi::RS && tid < 256) { const float _s = (((rq0.x + rq0.y) + (rq0.z + rq0.w)) + ((rq1.x + rq1.y) + (rq1.z + rq1.w))) + (((rq2.x + rq2.y) + (rq2.z + rq2.w)) + ((rq3.x + rq3.y) + (rq3.z + rq3.w))); \
        rsl[(PAR) * 256 + tid] = rsqrtf(_s * (1.0f / 1024.0f) + 1e-6f); } } while (0)
    Unit cur, nxt; int ui = 0;
    if (!S.next(0, cur)) return;
    PG8_RS_ISSUE(cur); PG8_RS_COMMIT(0);
    f32x4 acc[2][2][4][2];
#pragma unroll
    for (int a = 0; a < 2; ++a)
#pragma unroll
        for (int b = 0; b < 2; ++b)
#pragma unroll
            for (int m = 0; m < 4; ++m)
#pragma unroll
                for (int n = 0; n < 2; ++n) acc[a][b][m][n] = (f32x4){0.f, 0.f, 0.f, 0.f};
    bf16x8 At[4][2], B0[2][2], B1[2][2];
    const char* cA = (const char*)g.A + (size_t)cur.pm * tstep; const char* cB = (const char*)g.Bt + (size_t)cur.pn * tstep;
    S.a_ready(cur);
    if constexpr (SP2) {
        PG8_STAGE(PG8_SB(0, 0), cB, voffB); PG8_STAGE(PG8_SB(0, 1), cB + hstep, voffB); PG8_STAGE(PG8_SA(0, 0), cA, voffA); PG8_STAGE(PG8_SA(0, 1), cA + hstep, voffA);
        if (wr == 1) PG8_BAR;
        PG8_WAIT_V(2); PG8_BAR;
        PG8_STAGE(PG8_SB(1, 0), cB + kstep, voffB); PG8_STAGE(PG8_SA(1, 0), cA + kstep, voffA); PG8_STAGE(PG8_SB(1, 1), cB + hstep + kstep, voffB);
        PG8_WAIT_V(6); PG8_BAR;
    } else {
        PG8_STAGE(PG8_SB(0, 0), cB, voffB); PG8_STAGE(PG8_SA(0, 0), cA, voffA); PG8_STAGE(PG8_SB(0, 1), cB + hstep, voffB); PG8_STAGE(PG8_SA(0, 1), cA + hstep, voffA);
        if (wr == 1) PG8_BAR;
        PG8_WAIT_V(4); PG8_BAR;
        PG8_STAGE(PG8_SB(1, 0), cB + kstep, voffB); PG8_STAGE(PG8_SA(1, 0), cA + kstep, voffA); PG8_STAGE(PG8_SB(1, 1), cB + hstep + kstep, voffB);
        PG8_WAIT_V(6); PG8_BAR;
    }
    for (;;) {
        const bool has_next = S.next(ui + 1, nxt);
        const char* nA = has_next ? (const char*)g.A + (size_t)nxt.pm * tstep : cA; const char* nB = has_next ? (const char*)g.Bt + (size_t)nxt.pn * tstep : cB;
        for (int t = 0; t < nt; t += 2) {
            const bool last = (t == nt - 2);
            const char* a1 = cA + (size_t)(t + 1) * kstep;
            const char* a2 = last ? nA : cA + (size_t)(t + 2) * kstep; const char* b2 = last ? nB : cB + (size_t)(t + 2) * kstep;
            const char* a3 = a2 + kstep; const char* b3 = b2 + kstep;
            if (last && has_next) { S.a_ready(nxt); PG8_RS_ISSUE(nxt); }
            if constexpr (SP2) {
            PG8_LDB(B0, 0, 0); PG8_LDB(B1, 0, 1); PG8_SCHED; PG8_LDA(At, 0, 0); PG8_STAGE(PG8_SA(1, 1), a1 + hstep, voffA);
            PG8_WAIT_V(8); PG8_WAIT_L(0); PG8_BAR; PG8_MMA(0, 0, At, B0); PG8_MMA(0, 1, At, B1); PG8_BAR; PG8_SCHED;
            PG8_LDA(At, 0, 1); PG8_STAGE(PG8_SB(0, 0), b2, voffB); PG8_STAGE(PG8_SB(0, 1), b2 + hstep, voffB); PG8_STAGE(PG8_SA(0, 0), a2, voffA);
            PG8_WAIT_V(8); PG8_WAIT_L(0); PG8_BAR; PG8_MMA(1, 0, At, B0); PG8_MMA(1, 1, At, B1); PG8_BAR; PG8_SCHED;
            PG8_LDB(B0, 1, 0); PG8_LDB(B1, 1, 1); PG8_SCHED; PG8_LDA(At, 1, 0); PG8_STAGE(PG8_SA(0, 1), a2 + hstep, voffA);
            PG8_WAIT_V(8); PG8_WAIT_L(0); PG8_BAR; PG8_MMA(0, 0, At, B0); PG8_MMA(0, 1, At, B1); PG8_BAR; PG8_SCHED;
            PG8_LDA(At, 1, 1); PG8_STAGE(PG8_SB(1, 0), b3, voffB); PG8_STAGE(PG8_SB(1, 1), b3 + hstep, voffB); PG8_STAGE(PG8_SA(1, 0), a3, voffA);
            PG8_WAIT_V(8); PG8_WAIT_L(0); PG8_BAR; PG8_MMA(1, 0, At, B0); PG8_MMA(1, 1, At, B1); PG8_BAR; PG8_SCHED;
            if (last && has_next) PG8_RS_COMMIT((ui + 1) & 1);
            } else {
            PG8_LDB(B0, 0, 0); PG8_SCHED; PG8_LDA(At, 0, 0); PG8_STAGE(PG8_SA(1, 1), a1 + hstep, voffA);
            PG8_WAIT_L(8); PG8_BAR; PG8_WAIT_L(0); PG8_MMA(0, 0, At, B0); PG8_BAR; PG8_SCHED;
            PG8_LDB(B1, 0, 1); PG8_STAGE(PG8_SB(0, 0), b2, voffB);
            PG8_BAR; PG8_WAIT_L(0); PG8_MMA(0, 1, At, B1); PG8_BAR;
            PG8_LDA(At, 0, 1); PG8_STAGE(PG8_SA(0, 0), a2, voffA);
            PG8_BAR; PG8_WAIT_L(0); PG8_MMA(1, 0, At, B0); PG8_BAR; PG8_SCHED;
            PG8_STAGE(PG8_SB(0, 1), b2 + hstep, voffB);
            PG8_WAIT_V(6); PG8_BAR; PG8_MMA(1, 1, At, B1); PG8_BAR;
            PG8_LDB(B0, 1, 0); PG8_SCHED; PG8_LDA(At, 1, 0); PG8_STAGE(PG8_SA(0, 1), a2 + hstep, voffA);
            PG8_WAIT_L(8); PG8_BAR; PG8_WAIT_L(0); PG8_MMA(0, 0, At, B0); PG8_BAR; PG8_SCHED;
            PG8_LDB(B1, 1, 1); PG8_STAGE(PG8_SB(1, 0), b3, voffB);
            PG8_BAR; PG8_WAIT_L(0); PG8_MMA(0, 1, At, B1); PG8_BAR;
            PG8_LDA(At, 1, 1); PG8_STAGE(PG8_SA(1, 0), a3, voffA);
            PG8_BAR; PG8_WAIT_L(0); PG8_MMA(1, 0, At, B0); PG8_BAR; PG8_SCHED;
            PG8_STAGE(PG8_SB(1, 1), b3 + hstep, voffB);
            PG8_WAIT_V(6); PG8_BAR; PG8_MMA(1, 1, At, B1); PG8_BAR;
            }
        }
        if constexpr (ALIGN_EPI) { if (wr == 0) PG8_BAR; }
        E(acc, cur, wr, wc, fr, fq, rsl + (ui & 1) * 256);
        if (!has_next) break;
#pragma unroll
        for (int a = 0; a < 2; ++a)
#pragma unroll
            for (int b = 0; b < 2; ++b)
#pragma unroll
                for (int m = 0; m < 4; ++m)
#pragma unroll
                    for (int n = 0; n < 2; ++n) acc[a][b][m][n] = (f32x4){0.f, 0.f, 0.f, 0.f};
        cur = nxt; cA = nA; cB = nB; ++ui;
        if constexpr (ALIGN_EPI) { if (wr == 1) PG8_BAR; }
    }
    PG8_WAIT_V(0);
    if constexpr (!ALIGN_EPI) { if (wr == 0) PG8_BAR; }
    PG8_BAR;
#undef PG8_RS_ISSUE
#undef PG8_RS_COMMIT
#undef PG8_SA
#undef PG8_SB
#undef PG8_STAGE
#undef PG8_LDA
#undef PG8_LDB
#undef PG8_MMA
#undef PG8_WAIT_V
#undef PG8_WAIT_L
#undef PG8_BAR
#undef PG8_SCHED
}

__device__ __forceinline__ void load_rstd8(const float* SS, int row0, int fq, float (&rs)[2][4]) {
    f32x4 t[2][4];
#pragma unroll
    for (int ai = 0; ai < 2; ++ai)
#pragma unroll
        for (int m = 0; m < 4; ++m) t[ai][m] = *(const f32x4*)(SS + (size_t)(row0 + ai * HALF + m * 16) * 16 + 4 * fq);
    asm volatile("" ::: "memory");
#pragma unroll
    for (int ai = 0; ai < 2; ++ai)
#pragma unroll
        for (int m = 0; m < 4; ++m) { float sm = (t[ai][m].x + t[ai][m].y) + (t[ai][m].z + t[ai][m].w); sm += __shfl_xor(sm, 16); sm += __shfl_xor(sm, 32);
            rs[ai][m] = rsqrtf(sm * (1.0f / 1024.0f) + EPS); }
}
struct EpiSwiGLU {
    static constexpr bool PERM = true, RS = true;
    bf16_t* O; const float* SS;
    __device__ __forceinline__ void operator()(const f32x4 (&acc)[2][2][4][2], const Unit& u, int wr, int wc, int fr, int fq, const PG8_LAS float* rsl) const {
        const int row0 = u.pm * BM + wr * 64 + fr; const int col0 = u.pn * 128 + wc * 32 + 8 * fq;
        float rsv[2][4];
#pragma unroll
        for (int ai = 0; ai < 2; ++ai)
#pragma unroll
            for (int m = 0; m < 4; ++m) rsv[ai][m] = rsl[ai * HALF + wr * 64 + m * 16 + fr];
#pragma unroll
        for (int ai = 0; ai < 2; ++ai)
#pragma unroll
            for (int m = 0; m < 4; ++m) {
                const int row = row0 + ai * HALF + m * 16; const float rs = rsv[ai][m], k1 = -LOG2E * rs, rs2 = rs * rs;
                const f32x4 g0 = acc[ai][0][m][0], g1 = acc[ai][0][m][1], u0 = acc[ai][1][m][0], u1 = acc[ai][1][m][1];
                const f32x2 o0 = swiglu2((f32x2){g0[0], g0[1]}, (f32x2){u0[0], u0[1]}, k1, rs2), o1 = swiglu2((f32x2){g0[2], g0[3]}, (f32x2){u0[2], u0[3]}, k1, rs2);
                const f32x2 o2 = swiglu2((f32x2){g1[0], g1[1]}, (f32x2){u1[0], u1[1]}, k1, rs2), o3 = swiglu2((f32x2){g1[2], g1[3]}, (f32x2){u1[2], u1[3]}, k1, rs2);
                u32x4 w;
                w.x = pk_bf16(o0.x, o0.y); w.y = pk_bf16(o1.x, o1.y); w.z = pk_bf16(o2.x, o2.y); w.w = pk_bf16(o3.x, o3.y);
                *(u32x4*)(O + (size_t)row * DFF + col0) = w;
            }
    }
};
struct EpiResidual {
    static constexpr bool PERM = true, RS = false;
    const float* baseP; const float* baseS; bf16_t* XB; float* SS; float alpha; int f32base;
    __device__ __forceinline__ void operator()(const f32x4 (&acc)[2][2][4][2], const Unit& u, int wr, int wc, int fr, int fq, const PG8_LAS float* rsl) const {
        const int row0 = u.pm * BM + wr * 64 + fr; const int colb = u.pn * BM + wc * 32 + 8 * fq;
        const bool samp = u.pm >= 256;
        if (f32base) {
#pragma unroll
            for (int ai = 0; ai < 2; ++ai)
#pragma unroll
                for (int mh = 0; mh < 2; ++mh) {
                    f32x4 fb[2][2][2];
#pragma unroll
                    for (int m2 = 0; m2 < 2; ++m2) { const int row = row0 + ai * HALF + (2 * mh + m2) * 16;
                        const float* bp = (samp ? baseS + (size_t)(row - MP) * DM : baseP + (size_t)row * DM) + colb;
#pragma unroll
                        for (int bj = 0; bj < 2; ++bj) { fb[m2][bj][0] = *(const f32x4*)(bp + bj * HALF); fb[m2][bj][1] = *(const f32x4*)(bp + bj * HALF + 4); } }
                    asm volatile("" : "+v"(fb[0][0][0]), "+v"(fb[0][0][1]), "+v"(fb[0][1][0]), "+v"(fb[0][1][1]), "+v"(fb[1][0][0]), "+v"(fb[1][0][1]), "+v"(fb[1][1][0]), "+v"(fb[1][1][1]) :: "memory");
#pragma unroll
                    for (int m2 = 0; m2 < 2; ++m2) { const int m = 2 * mh + m2; const int row = row0 + ai * HALF + m * 16; float ss = 0.f;
#pragma unroll
                        for (int bj = 0; bj < 2; ++bj) {
                            const f32x4 x0 = fb[m2][bj][0] + acc[ai][bj][m][0] * alpha, x1 = fb[m2][bj][1] + acc[ai][bj][m][1] * alpha;
                            u32x4 w; w.x = pk_bf16(x0[0], x0[1]); w.y = pk_bf16(x0[2], x0[3]); w.z = pk_bf16(x1[0], x1[1]); w.w = pk_bf16(x1[2], x1[3]);
                            *(u32x4*)(XB + (size_t)row * DM + colb + bj * HALF) = w;
                            ss += (x0[0] * x0[0] + x0[1] * x0[1]) + (x0[2] * x0[2] + x0[3] * x0[3]) + (x1[0] * x1[0] + x1[1] * x1[1]) + (x1[2] * x1[2] + x1[3] * x1[3]);
                        }
                        ss += __shfl_xor(ss, 16); ss += __shfl_xor(ss, 32);
                        if (fq == 0) SS[(size_t)row * 16 + u.pn * 4 + wc] = ss; }
                }
            return;
        }
#pragma unroll
        for (int ai = 0; ai < 2; ++ai) {
            u32x4 wv[4][2];
#pragma unroll
            for (int m = 0; m < 4; ++m)
#pragma unroll
                for (int bj = 0; bj < 2; ++bj) wv[m][bj] = *(const u32x4*)(XB + (size_t)(row0 + ai * HALF + m * 16) * DM + colb + bj * HALF);
            asm volatile("" : "+v"(wv[0][0]), "+v"(wv[0][1]), "+v"(wv[1][0]), "+v"(wv[1][1]), "+v"(wv[2][0]), "+v"(wv[2][1]), "+v"(wv[3][0]), "+v"(wv[3][1]) :: "memory");
#pragma unroll
            for (int m = 0; m < 4; ++m) {
                const int row = row0 + ai * HALF + m * 16;
                float ss = 0.f;
#pragma unroll
                for (int bj = 0; bj < 2; ++bj) {
                    const u32x4 wq = wv[m][bj];
                    const f32x4 b0 = (f32x4){bf_lo(wq.x), bf_hi(wq.x), bf_lo(wq.y), bf_hi(wq.y)}, b1 = (f32x4){bf_lo(wq.z), bf_hi(wq.z), bf_lo(wq.w), bf_hi(wq.w)};
                    const f32x4 x0 = b0 + acc[ai][bj][m][0] * alpha, x1 = b1 + acc[ai][bj][m][1] * alpha;
                    u32x4 w; w.x = pk_bf16(x0[0], x0[1]); w.y = pk_bf16(x0[2], x0[3]); w.z = pk_bf16(x1[0], x1[1]); w.w = pk_bf16(x1[2], x1[3]);
                    *(u32x4*)(XB + (size_t)row * DM + colb + bj * HALF) = w;
                    ss += (x0[0] * x0[0] + x0[1] * x0[1]) + (x0[2] * x0[2] + x0[3] * x0[3]) + (x1[0] * x1[0] + x1[1] * x1[1]) + (x1[2] * x1[2] + x1[3] * x1[3]);
                }
                ss += __shfl_xor(ss, 16); ss += __shfl_xor(ss, 32);
                if (fq == 0) SS[(size_t)row * 16 + u.pn * 4 + wc] = ss;
            }
        }
    }
};
struct EpiProjEven {
    static constexpr bool PERM = true, RS = true;
    bf16_t* QKVU; const float* SS; float* out;
    __device__ __forceinline__ void operator()(const f32x4 (&acc)[2][2][4][2], const Unit& u, int wr, int wc, int fr, int fq, const PG8_LAS float* rsl) const {
        const int sec = u.pn >> 1; const bool samp = u.pm >= 256;
        const int row0 = u.pm * BM + wr * 64 + fr; const int colb = u.pn * BM + wc * 32 + 8 * fq;
        float* o32 = nullptr;
        if (sec == 1) o32 = out + (samp ? OFF_KS : OFF_KP); else if (sec == 2) o32 = out + (samp ? OFF_VS : OFF_VP);
        float* opool = out + (samp ? OFF_PS : OFF_PP);
        const float qs = (sec == 0) ? QSCALE : 1.0f;
        float rsv[2][4];
#pragma unroll
        for (int ai = 0; ai < 2; ++ai)
#pragma unroll
            for (int m = 0; m < 4; ++m) rsv[ai][m] = rsl[ai * HALF + wr * 64 + m * 16 + fr];
#pragma unroll
        for (int ai = 0; ai < 2; ++ai)
#pragma unroll
            for (int m = 0; m < 4; ++m) {
                const int row = row0 + ai * HALF + m * 16; const float rs = rsv[ai][m] * qs;
                const int orow = samp ? row - MP : row;
                bool poolrow = false; int prow = 0;
                if (sec == 3) {
                    if (!samp) { const int t = row & 2047; poolrow = t >= 2033; prow = (row >> 11) * 15 + t - 2033; }
                    else { const int rr = row - MP, t = rr & 31; poolrow = t >= 17; prow = (rr >> 5) * 15 + t - 17; }
                }
#pragma unroll
                for (int bj = 0; bj < 2; ++bj) {
                    const int col = colb + bj * HALF;
                    const f32x4 v0 = acc[ai][bj][m][0] * rs, v1 = acc[ai][bj][m][1] * rs;
                    u32x4 w; w.x = pk_bf16(v0[0], v0[1]); w.y = pk_bf16(v0[2], v0[3]); w.z = pk_bf16(v1[0], v1[1]); w.w = pk_bf16(v1[2], v1[3]);
                    *(u32x4*)(QKVU + (size_t)row * 2048 + col) = w;
                    if (o32) { float* p = o32 + (size_t)orow * 512 + (col & 511); __builtin_nontemporal_store(v0, (f32x4*)p); __builtin_nontemporal_store(v1, (f32x4*)(p + 4)); }
                    if (poolrow) { float* p = opool + (size_t)prow * 512 + (col & 511); *(f32x4*)p = v0; *(f32x4*)(p + 4) = v1; }
                }
            }
    }
};
struct EpiSguProj {
    static constexpr bool PERM = true, RS = true;
    bf16_t* ZUV; const float* SS; float* SS2;
    __device__ __forceinline__ void operator()(const f32x4 (&acc)[2][2][4][2], const Unit& u, int wr, int wc, int fr, int fq, const PG8_LAS float* rsl) const {
        const int row0 = u.pm * BM + wr * 64 + fr; const int colb = u.pn * BM + wc * 32 + 8 * fq;
        const bool isv = u.pn >= 4;
        float rsv[2][4];
#pragma unroll
        for (int ai = 0; ai < 2; ++ai)
#pragma unroll
            for (int m = 0; m < 4; ++m) rsv[ai][m] = rsl[ai * HALF + wr * 64 + m * 16 + fr];
#pragma unroll
        for (int ai = 0; ai < 2; ++ai)
#pragma unroll
            for (int m = 0; m < 4; ++m) {
                const int row = row0 + ai * HALF + m * 16; const float rs = rsv[ai][m];
                float ss = 0.f;
#pragma unroll
                for (int bj = 0; bj < 2; ++bj) {
                    const int col = colb + bj * HALF;
                    f32x4 v0 = acc[ai][bj][m][0] * rs, v1 = acc[ai][bj][m][1] * rs;
                    { const f32x2 a0 = gelu2((f32x2){v0[0], v0[1]}), a1 = gelu2((f32x2){v0[2], v0[3]}), a2 = gelu2((f32x2){v1[0], v1[1]}), a3 = gelu2((f32x2){v1[2], v1[3]});
                      v0 = (f32x4){a0.x, a0.y, a1.x, a1.y}; v1 = (f32x4){a2.x, a2.y, a3.x, a3.y}; }
                    u32x4 w; w.x = pk_bf16(v0[0], v0[1]); w.y = pk_bf16(v0[2], v0[3]); w.z = pk_bf16(v1[0], v1[1]); w.w = pk_bf16(v1[2], v1[3]);
                    *(u32x4*)(ZUV + (size_t)row * 2048 + col) = w;
                    ss += (v0[0] * v0[0] + v0[1] * v0[1]) + (v0[2] * v0[2] + v0[3] * v0[3]) + (v1[0] * v1[0] + v1[1] * v1[1]) + (v1[2] * v1[2] + v1[3] * v1[3]);
                }
                if (isv) { ss += __shfl_xor(ss, 16); ss += __shfl_xor(ss, 32); if (fq == 0) SS2[(size_t)row * 16 + (u.pn - 4) * 4 + wc] = ss; }
            }
    }
};
}

__device__ __forceinline__ void p0_tr_item(const float* W, int ldw, int k0, int src_col0, bf16_t* WT, int K, int dst_row0, const float* gk, const float* sn, LAS float* scr, int lane) {
    const int c = lane & 7;
    f32x4 wq[8]; f32x4 ga = (f32x4){1.f, 1.f, 1.f, 1.f}, gb = ga;
    const float* wp = W + (size_t)(k0 + (lane >> 5)) * ldw + src_col0 + (lane & 31);
#pragma unroll
    for (int i = 0; i < 32; ++i) wq[i >> 2][i & 3] = wp[(size_t)(2 * i) * ldw];
    if (gk) { ga = *(const f32x4*)(gk + k0 + 8 * c); gb = *(const f32x4*)(gk + k0 + 8 * c + 4); }
    asm volatile("" : "+v"(wq[0]), "+v"(wq[1]), "+v"(wq[2]), "+v"(wq[3]), "+v"(wq[4]), "+v"(wq[5]), "+v"(wq[6]), "+v"(wq[7]), "+v"(ga), "+v"(gb) :: "memory");
#pragma unroll
    for (int i = 0; i < 32; ++i) scr[(2 * i + (lane >> 5)) * 33 + (lane & 31)] = wq[i >> 2][i & 3];
    asm volatile("s_waitcnt lgkmcnt(0)" ::: "memory");
#pragma unroll
    for (int j = 0; j < 4; ++j) { const int n = (lane >> 3) + 8 * j; const LAS float* sp = scr + (8 * c) * 33 + n; const float sc = sn ? sn[n] : 1.0f;
        u32x4 o; o.x = pk_bf16(sp[0 * 33] * ga.x * sc, sp[1 * 33] * ga.y * sc); o.y = pk_bf16(sp[2 * 33] * ga.z * sc, sp[3 * 33] * ga.w * sc);
        o.z = pk_bf16(sp[4 * 33] * gb.x * sc, sp[5 * 33] * gb.y * sc); o.w = pk_bf16(sp[6 * 33] * gb.z * sc, sp[7 * 33] * gb.w * sc);
        *(u32x4*)(WT + (size_t)(dst_row0 + n) * K + k0 + 8 * c) = o; }
    asm volatile("s_waitcnt lgkmcnt(0)" ::: "memory");
}

__device__ __forceinline__ void p0_weight_items(const Args& a, LAS unsigned char* lds, int mode_lo, int mode_hi, int worker, int nworkers) {
    const int tid = fresh_tid(), lane = tid & 63, wid = __builtin_amdgcn_readfirstlane(tid >> 6);
    unsigned char* ws = a.ws;
    LAS float* scr = (LAS float*)(lds + wid * 8704);
    const float* norm_g = a.in[6];
    for (int mode = mode_lo; mode < mode_hi; ++mode)
    for (int ix = worker; ix < (mode == 0 ? 5792 : 14208); ix += nworkers) {
        const float* W; int ldw, k0, sc0, K, dr0; bf16_t* WT; const float* gk = nullptr; const float* sn = nullptr;
        int r;
        if (mode == 0) r = ix < 2816 ? ix : (ix < 4224 ? 11264 + (ix - 2816) : (ix < 5760 ? 16896 + (ix - 4224) : 19968 + (ix - 5760)));
        else r = ix < 8448 ? 2816 + ix : (ix < 12672 ? 12672 + (ix - 8448) : 18432 + (ix - 12672));
        if (r < 11264) { const int mi = r / 2816; r -= mi * 2816; const int kb = r / 176, nb = r % 176, n0 = nb * 32, pn = n0 >> 8, bj = (n0 >> 7) & 1, jj = n0 & 127;
            W = a.in[7] + (size_t)mi * DM * NFF; ldw = NFF; k0 = kb * 64; sc0 = bj * DFF + pn * 128 + jj; WT = (bf16_t*)(ws + WS_W1) + (size_t)mi * NFF * DM; K = DM; dr0 = n0;
            gk = norm_g + ((mi >> 1) * 3 + ((mi & 1) ? 2 : 0)) * DM; }
        else if ((r -= 11264) < 5632) { const int mi = r / 1408; r -= mi * 1408; const int kb = r / 32, nb = r % 32;
            W = a.in[8] + (size_t)mi * DFF * DM; ldw = DM; k0 = kb * 64; sc0 = nb * 32; WT = (bf16_t*)(ws + WS_W2) + (size_t)mi * DM * DFF; K = DFF; dr0 = nb * 32; }
        else if ((r -= 5632) < 1024) { const int kb = r / 64, nb = r % 64, n0 = nb * 32;
            W = a.in[9]; ldw = 2056; k0 = kb * 64; sc0 = n0 < 1536 ? n0 : n0 + 8; WT = (bf16_t*)(ws + WS_WEIN); K = DM; dr0 = n0; gk = norm_g + 1 * DM; }
        else if ((r -= 1024) < 512) { const int kb = r / 32, nb = r % 32;
            W = a.in[13]; ldw = DM; k0 = kb * 64; sc0 = nb * 32; WT = (bf16_t*)(ws + WS_WEOUT); K = DM; dr0 = nb * 32; }
        else if ((r -= 512) < 1024) { const int kb = r / 64, nb = r % 64;
            W = a.in[14]; ldw = 2048; k0 = kb * 64; sc0 = nb * 32; WT = (bf16_t*)(ws + WS_WSIN); K = DM; dr0 = nb * 32; gk = norm_g + 4 * DM; }
        else if ((r -= 1024) < 512) { const int kb = r / 32, nb = r % 32;
            W = a.in[18]; ldw = DM; k0 = kb * 64; sc0 = nb * 32; WT = (bf16_t*)(ws + WS_WSOUT); K = DM; dr0 = nb * 32; }
        else { r -= 512; const int g = r >> 3, kb = (r >> 2) & 1, nb = r & 3;
            W = a.in[11] + (size_t)g * 128 * 128; ldw = 128; k0 = kb * 64; sc0 = nb * 32; WT = (bf16_t*)(ws + WS_POOLWT) + (size_t)g * 128 * 128; K = 128; dr0 = nb * 32; sn = a.in[12] + g * 128 + nb * 32; }
        p0_tr_item(W, ldw, k0, sc0, WT, K, dr0, gk, sn, scr, lane);
    }
}

__device__ __forceinline__ void p0_phase(const Args& a, LAS unsigned char* lds) {
    const int tid = fresh_tid(), lane = tid & 63, wid = __builtin_amdgcn_readfirstlane(tid >> 6);
    const int gw = blockIdx.x * 8 + wid, NGW = gridDim.x * 8;
    unsigned char* ws = a.ws;
    const float* norm_g = a.in[6];
    p0_weight_items(a, lds, 0, gridDim.x == 256 ? 1 : 2, gw, NGW);
    const int gt = blockIdx.x * 512 + tid, NGT = gridDim.x * 512;
    { bf16_t* WF = (bf16_t*)(ws + WS_WF); const float* W = a.in[9];
      for (int idx = gt; idx < 16 * DM; idx += NGT) { const int rr = idx >> 10, k = idx & 1023; const float v = rr < 8 ? W[(size_t)k * 2056 + 1536 + rr] * norm_g[DM + k] : 0.f; WF[idx] = (bf16_t)(pk_bf16(v, 0.f) & 0xffffu); } }
    { bf16_t* SW = (bf16_t*)(ws + WS_SGUW); const float* W = a.in[16];
      for (int idx = gt; idx < 8 * 128 * 128; idx += NGT) { const int t = (idx >> 7) & 127, s = idx & 127; const float v = ((s >> 6) <= (t >> 6)) ? W[idx] : 0.f; SW[idx] = (bf16_t)(pk_bf16(v, 0.f) & 0xffffu); } }
    bf16_t* XB = (bf16_t*)(ws + WS_XB); float* SS = (float*)(ws + WS_SS);
    for (int row0 = gw; row0 < MT; row0 += 4 * NGW) {
        f32x4 v[4][4];
#pragma unroll
        for (int i = 0; i < 4; ++i) { const int row = min(row0 + i * NGW, MT - 1); const float* xr = row < MP ? a.in[0] + (size_t)row * DM : a.in[1] + (size_t)(row - MP) * DM;
#pragma unroll
            for (int j = 0; j < 4; ++j) v[i][j] = __builtin_nontemporal_load((const f32x4*)(xr + (lane + 64 * j) * 4)); }
        asm volatile("" : "+v"(v[0][0]), "+v"(v[0][1]), "+v"(v[0][2]), "+v"(v[0][3]), "+v"(v[1][0]), "+v"(v[1][1]), "+v"(v[1][2]), "+v"(v[1][3]),
                     "+v"(v[2][0]), "+v"(v[2][1]), "+v"(v[2][2]), "+v"(v[2][3]), "+v"(v[3][0]), "+v"(v[3][1]), "+v"(v[3][2]), "+v"(v[3][3]) :: "memory");
#pragma unroll
        for (int i = 0; i < 4; ++i) { const int row = row0 + i * NGW; if (row < MT) { float sq = 0.f;
#pragma unroll
            for (int j = 0; j < 4; ++j) { sq += (v[i][j].x * v[i][j].x + v[i][j].y * v[i][j].y) + (v[i][j].z * v[i][j].z + v[i][j].w * v[i][j].w);
                u32x2 w; w.x = pk_bf16(v[i][j].x, v[i][j].y); w.y = pk_bf16(v[i][j].z, v[i][j].w); *(u32x2*)(XB + (size_t)row * DM + (lane + 64 * j) * 4) = w; }
            sq = wave_sum(sq);
            if (lane < 16) SS[(size_t)row * 16 + lane] = lane == 0 ? sq : 0.f; } }
    }
}

__device__ __forceinline__ void f_unit(int tile, const bf16_t* XB, const bf16_t* WF, const float* SS, const float* bf, float* out) {
    const int tid = fresh_tid(), lane = tid & 63, wid = __builtin_amdgcn_readfirstlane(tid >> 6), fr = lane & 15, fq = lane >> 4;
#pragma unroll 1
    for (int mf = 0; mf < 2; ++mf) {
        const int rowb = tile * 256 + wid * 32 + mf * 16;
        const bf16_t* ap = XB + (size_t)(rowb + fr) * DM + fq * 8; const bf16_t* bp = WF + (size_t)fr * DM + fq * 8;
        f32x4 acc = (f32x4){0.f, 0.f, 0.f, 0.f};
#pragma unroll 1
        for (int kb = 0; kb < 4; ++kb) {
            bf16x8 av[8], bv[8];
#pragma unroll
            for (int uu = 0; uu < 8; ++uu) { av[uu] = *(const bf16x8*)(ap + (kb * 8 + uu) * 32); bv[uu] = *(const bf16x8*)(bp + (kb * 8 + uu) * 32); }
            asm volatile("" : "+v"(av[0]), "+v"(av[1]), "+v"(av[2]), "+v"(av[3]), "+v"(av[4]), "+v"(av[5]), "+v"(av[6]), "+v"(av[7]),
                         "+v"(bv[0]), "+v"(bv[1]), "+v"(bv[2]), "+v"(bv[3]), "+v"(bv[4]), "+v"(bv[5]), "+v"(bv[6]), "+v"(bv[7]) :: "memory");
#pragma unroll
            for (int uu = 0; uu < 8; ++uu) acc = __builtin_amdgcn_mfma_f32_16x16x32_bf16(bv[uu], av[uu], acc, 0, 0, 0);
        }
        const int row = rowb + fr;
        if (fq < 2) {
            const float rs = row_rstd(SS, row); f32x4 o;
#pragma unroll
            for (int e = 0; e < 4; ++e) { const float z = acc[e] * rs + bf[4 * fq + e]; o[e] = fminf(z, 0.f) - log1pf(__expf(-fabsf(z))); }
            float* p = row < MP ? out + OFF_FP + (size_t)row * 8 + 4 * fq : out + OFF_FS + (size_t)(row - MP) * 8 + 4 * fq;
            *(f32x4*)p = o;
        }
    }
}

constexpr int AT_C2 = 0, AT_K = 8448, AT_KB = 64 * 144, AT_VT = AT_K + 2 * AT_KB, AT_VB = 64 * 136, AT_WT = AT_VT + 2 * AT_VB;
__device__ __forceinline__ int crow(int r, int hi) { return (r & 3) + 8 * (r >> 2) + 4 * hi; }

__device__ __forceinline__ void scan2048(float v0, float v1, float v2, float v3, LAS unsigned char* lds) {
    const int tid = fresh_tid(), lane = tid & 63, wid = tid >> 6;
    LAS float* c2s = (LAS float*)(lds + AT_C2); LAS float* wt = (LAS float*)(lds + AT_WT);
    const float a0 = v0, a1 = a0 + v1, a2 = a1 + v2, a3 = a2 + v3;
    float x = a3;
#pragma unroll
    for (int off = 1; off < 64; off <<= 1) { const float y = __shfl_up(x, off); if (lane >= off) x += y; }
    if (lane == 63) wt[wid] = x;
    __syncthreads();
    float pre = x - a3;
    for (int w = 0; w < wid; ++w) pre += wt[w];
    c2s[4 * tid + 0] = (pre + a0) * LOG2E; c2s[4 * tid + 1] = (pre + a1) * LOG2E; c2s[4 * tid + 2] = (pre + a2) * LOG2E; c2s[4 * tid + 3] = (pre + a3) * LOG2E;
    __syncthreads();
}

struct AttnJob {
    const bf16_t* Qrow0;
    bf16_t* Orow0;
    int nqw, qpos0, NT, mode;
    const bf16_t* Kb;
    const float* cK; const float* cV;
};

__device__ __forceinline__ void attn_load(const AttnJob& J, int t, u32x4& kreg, u32x4& vreg) {
    const int tid = fresh_tid(), key = tid >> 3, ch = tid & 7, kidx = 64 * t + key;
    if (J.mode == 0) { const bf16_t* p = J.Kb + (size_t)kidx * 2048 + ch * 8; kreg = *(const u32x4*)p; vreg = *(const u32x4*)(p + 512); }
    else if (kidx < PAST) { const float* pk = J.cK + (size_t)kidx * 512 + ch * 8; const float* pv = J.cV + (size_t)kidx * 512 + ch * 8;
        const f32x4 a = *(const f32x4*)pk, b = *(const f32x4*)(pk + 4), c = *(const f32x4*)pv, d = *(const f32x4*)(pv + 4);
        kreg = (u32x4){pk_bf16(a.x, a.y), pk_bf16(a.z, a.w), pk_bf16(b.x, b.y), pk_bf16(b.z, b.w)};
        vreg = (u32x4){pk_bf16(c.x, c.y), pk_bf16(c.z, c.w), pk_bf16(d.x, d.y), pk_bf16(d.z, d.w)}; }
    else if (kidx < PAST + TS) { const bf16_t* p = J.Kb + (size_t)(kidx - PAST) * 2048 + ch * 8; kreg = *(const u32x4*)p; vreg = *(const u32x4*)(p + 512); }
    else { kreg = (u32x4){0u, 0u, 0u, 0u}; vreg = kreg; }
}
__device__ __forceinline__ void attn_stage(LAS unsigned char* lds, int buf, const u32x4& kreg, const u32x4& vreg) {
    const int tid = fresh_tid(), key = tid >> 3, ch = tid & 7;
    *(LAS u32x4*)(lds + AT_K + buf * AT_KB + key * 144 + ch * 16) = kreg;
    LAS bf16_t* vt = (LAS bf16_t*)(lds + AT_VT + buf * AT_VB) + (ch * 8) * 68 + key;
    vt[0 * 68] = (bf16_t)(vreg.x & 0xffffu); vt[1 * 68] = (bf16_t)(vreg.x >> 16);
    vt[2 * 68] = (bf16_t)(vreg.y & 0xffffu); vt[3 * 68] = (bf16_t)(vreg.y >> 16);
    vt[4 * 68] = (bf16_t)(vreg.z & 0xffffu); vt[5 * 68] = (bf16_t)(vreg.z >> 16);
    vt[6 * 68] = (bf16_t)(vreg.w & 0xffffu); vt[7 * 68] = (bf16_t)(vreg.w >> 16);
}

__device__ __forceinline__ void attn_tile(int t, int buf, LAS unsigned char* lds, const bf16x8 (&qr)[4], float cq2, int qlo, int qpos, int q32, int hi,
                                          float& mrun, float& lrun, f32x16& o0, f32x16& o1) {
    const LAS float* c2s = (const LAS float*)(lds + AT_C2);
    const LAS unsigned char* Kt = lds + AT_K + buf * AT_KB; const LAS unsigned char* Vt = lds + AT_VT + buf * AT_VB;
    f32x16 s0, s1;
#pragma unroll
    for (int j = 0; j < 4; ++j) {
        const f32x4 c0 = *(const LAS f32x4*)(c2s + 64 * t + 8 * j + 4 * hi), c1 = *(const LAS f32x4*)(c2s + 64 * t + 32 + 8 * j + 4 * hi);
#pragma unroll
        for (int e = 0; e < 4; ++e) { s0[4 * j + e] = cq2 - c0[e]; s1[4 * j + e] = cq2 - c1[e]; }
    }
#pragma unroll
    for (int d0 = 0; d0 < 4; ++d0) {
        const bf16x8 k0 = *(const LAS bf16x8*)(Kt + q32 * 144 + d0 * 32 + hi * 16);
        const bf16x8 k1 = *(const LAS bf16x8*)(Kt + (32 + q32) * 144 + d0 * 32 + hi * 16);
        s0 = __builtin_amdgcn_mfma_f32_32x32x16_bf16(k0, qr[d0], s0, 0, 0, 0);
        s1 = __builtin_amdgcn_mfma_f32_32x32x16_bf16(k1, qr[d0], s1, 0, 0, 0);
    }
    if (64 * t + 63 > qlo) {
#pragma unroll
        for (int r = 0; r < 16; ++r) { const int kv = 64 * t + crow(r, hi); if (kv > qpos) s0[r] = -INFINITY; if (kv + 32 > qpos) s1[r] = -INFINITY; }
    }
    float mx = fmaxf(s0[0], s1[0]);
#pragma unroll
    for (int r = 1; r < 16; ++r) mx = fmaxf(mx, fmaxf(s0[r], s1[r]));
    mx = fmaxf(mx, __shfl_xor(mx, 32));
    const float mnew = fmaxf(mrun, mx);
    if (__any(mnew > mrun)) {
        const float alpha = fexp2(mrun - mnew); lrun *= alpha;
#pragma unroll
        for (int r = 0; r < 16; ++r) { o0[r] *= alpha; o1[r] *= alpha; }
    }
    mrun = mnew;
    float ls = 0.f;
#pragma unroll
    for (int r = 0; r < 16; ++r) { s0[r] = fexp2(s0[r] - mnew); s1[r] = fexp2(s1[r] - mnew); ls += s0[r] + s1[r]; }
    lrun += ls;
#pragma unroll
    for (int p = 0; p < 2; ++p)
#pragma unroll
        for (int sx = 0; sx < 2; ++sx) {
            u32x4 pw;
            if (p == 0) pw = (u32x4){pk_bf16(s0[8 * sx + 0], s0[8 * sx + 1]), pk_bf16(s0[8 * sx + 2], s0[8 * sx + 3]), pk_bf16(s0[8 * sx + 4], s0[8 * sx + 5]), pk_bf16(s0[8 * sx + 6], s0[8 * sx + 7])};
            else        pw = (u32x4){pk_bf16(s1[8 * sx + 0], s1[8 * sx + 1]), pk_bf16(s1[8 * sx + 2], s1[8 * sx + 3]), pk_bf16(s1[8 * sx + 4], s1[8 * sx + 5]), pk_bf16(s1[8 * sx + 6], s1[8 * sx + 7])};
            const bf16x8 pf = __builtin_bit_cast(bf16x8, pw);
            const int ko = (32 * p + 16 * sx + 4 * hi) * 2;
            const u32x2 a0 = *(const LAS u32x2*)(Vt + q32 * 136 + ko), a1 = *(const LAS u32x2*)(Vt + q32 * 136 + ko + 16);
            const u32x2 b0 = *(const LAS u32x2*)(Vt + (32 + q32) * 136 + ko), b1 = *(const LAS u32x2*)(Vt + (32 + q32) * 136 + ko + 16);
            const bf16x8 vf0 = __builtin_bit_cast(bf16x8, (u32x4){a0.x, a0.y, a1.x, a1.y});
            const bf16x8 vf1 = __builtin_bit_cast(bf16x8, (u32x4){b0.x, b0.y, b1.x, b1.y});
            o0 = __builtin_amdgcn_mfma_f32_32x32x16_bf16(vf0, pf, o0, 0, 0, 0);
            o1 = __builtin_amdgcn_mfma_f32_32x32x16_bf16(vf1, pf, o1, 0, 0, 0);
        }
}

__device__ __forceinline__ void attn_unit(const AttnJob& J, LAS unsigned char* lds) {
    const int tid = fresh_tid(), lane = tid & 63, q32 = lane & 31, hi = lane >> 5; const int wid = __builtin_amdgcn_readfirstlane(tid >> 6);
    const LAS float* c2s = (const LAS float*)(lds + AT_C2);
    const bool active = wid < J.nqw;
    const int qlo = J.qpos0 + 32 * wid, qpos = qlo + q32;
    bf16x8 qr[4]; float cq2 = 0.f;
    if (active) {
#pragma unroll
        for (int d0 = 0; d0 < 4; ++d0) qr[d0] = *(const bf16x8*)(J.Qrow0 + (size_t)(32 * wid + q32) * 2048 + d0 * 16 + hi * 8);
        cq2 = c2s[qpos];
    } else {
#pragma unroll
        for (int d0 = 0; d0 < 4; ++d0) qr[d0] = (bf16x8){0, 0, 0, 0, 0, 0, 0, 0};
    }
    float mrun = -1e30f, lrun = 0.f; f32x16 o0, o1;
#pragma unroll
    for (int r = 0; r < 16; ++r) { o0[r] = 0.f; o1[r] = 0.f; }
    u32x4 kA, vA, kB, vB;
    attn_load(J, 0, kA, vA);
    if (J.NT > 1) attn_load(J, 1, kB, vB); else { kB = (u32x4){0u, 0u, 0u, 0u}; vB = kB; }
    for (int t = 0; t < J.NT; t += 2) {
        attn_stage(lds, 0, kA, vA);
        __syncthreads();
        if (t + 2 < J.NT) attn_load(J, t + 2, kA, vA);
        if (active && 64 * t <= qlo + 31) attn_tile(t, 0, lds, qr, cq2, qlo, qpos, q32, hi, mrun, lrun, o0, o1);
        if (t + 1 < J.NT) {
            attn_stage(lds, 1, kB, vB);
            __syncthreads();
            if (t + 3 < J.NT) attn_load(J, t + 3, kB, vB);
            if (active && 64 * (t + 1) <= qlo + 31) attn_tile(t + 1, 1, lds, qr, cq2, qlo, qpos, q32, hi, mrun, lrun, o0, o1);
        }
    }
    if (active) {
        const float lt = lrun + __shfl_xor(lrun, 32); const float inv = 1.0f / lt;
        bf16_t* op = J.Orow0 + (size_t)(32 * wid + q32) * DM;
#pragma unroll
        for (int j = 0; j < 4; ++j) {
            u32x2 w0, w1;
            w0.x = pk_bf16(o0[4 * j + 0] * inv, o0[4 * j + 1] * inv); w0.y = pk_bf16(o0[4 * j + 2] * inv, o0[4 * j + 3] * inv);
            w1.x = pk_bf16(o1[4 * j + 0] * inv, o1[4 * j + 1] * inv); w1.y = pk_bf16(o1[4 * j + 2] * inv, o1[4 * j + 3] * inv);
            *(u32x2*)(op + 8 * j + 4 * hi) = w0; *(u32x2*)(op + 32 + 8 * j + 4 * hi) = w1;
        }
    }
    __syncthreads();
}

__device__ __forceinline__ void pool_unit(int tile, int g, const bf16_t* QKVU, const float* state_pool, const bf16_t* POOLWT, bf16_t* MIX, LAS unsigned char* lds) {
    const int tid = fresh_tid(), lane = tid & 63, wid = __builtin_amdgcn_readfirstlane(tid >> 6), fr = lane & 15, fq = lane >> 4;
    LAS float* U = (LAS float*)lds; LAS bf16_t* Dm = (LAS bf16_t*)(lds + 96256);
    const bool samp = tile >= 512; const int r0 = tile * 128; const int t0 = r0 & 2047;
    bf16x8 wv[4][8];
#pragma unroll
    for (int ks = 0; ks < 4; ++ks)
#pragma unroll
        for (int nf = 0; nf < 8; ++nf) wv[ks][nf] = *(const bf16x8*)(POOLWT + (size_t)(g * 128 + 16 * nf + fr) * 128 + 32 * ks + 8 * fq);
    if (!samp) {
        u32x4 uw[5];
#pragma unroll
        for (int it = 0; it < 5; ++it) { const int idx = tid + 512 * it, row = idx >> 4, ch = idx & 15;
            const int grow = max(r0 - 15 + min(row, 142), 0);
            uw[it] = *(const u32x4*)(QKVU + (size_t)grow * 2048 + 1536 + g * 128 + ch * 8); }
        asm volatile("" : "+v"(uw[0]), "+v"(uw[1]), "+v"(uw[2]), "+v"(uw[3]), "+v"(uw[4]) :: "memory");
#pragma unroll
        for (int it = 0; it < 5; ++it) { const int idx = tid + 512 * it, row = idx >> 4, ch = idx & 15;
            if (idx < 143 * 16) { f32x4 lo = (f32x4){0.f, 0.f, 0.f, 0.f}, hi4 = lo; const u32x4 w = uw[it];
                if (t0 - 15 + row >= 0) { lo = (f32x4){bf_lo(w.x), bf_hi(w.x), bf_lo(w.y), bf_hi(w.y)}; hi4 = (f32x4){bf_lo(w.z), bf_hi(w.z), bf_lo(w.w), bf_hi(w.w)}; }
                *(LAS f32x4*)(U + row * 128 + ch * 8) = lo; *(LAS f32x4*)(U + row * 128 + ch * 8 + 4) = hi4; } }
    } else {
        for (int idx = tid; idx < 188 * 16; idx += 512) { const int row = idx >> 4, ch = idx & 15, sb = row / 47, rr = row - sb * 47, b = (tile - 512) * 4 + sb; f32x4 lo, hi4;
            if (rr < 15) { const float* p = state_pool + (size_t)(b * 15 + rr) * 512 + g * 128 + ch * 8; lo = *(const f32x4*)p; hi4 = *(const f32x4*)(p + 4); }
            else { const u32x4 w = *(const u32x4*)(QKVU + (size_t)(MP + b * 32 + rr - 15) * 2048 + 1536 + g * 128 + ch * 8);
                lo = (f32x4){bf_lo(w.x), bf_hi(w.x), bf_lo(w.y), bf_hi(w.y)}; hi4 = (f32x4){bf_lo(w.z), bf_hi(w.z), bf_lo(w.w), bf_hi(w.w)}; }
            *(LAS f32x4*)(U + row * 128 + ch * 8) = lo; *(LAS f32x4*)(U + row * 128 + ch * 8 + 4) = hi4; }
    }
    __syncthreads();
    {
        const int c = tid & 127, rq = tid >> 7, w = 2 << g;
        const int ubase = samp ? rq * 47 : 0, tl0 = samp ? 0 : 32 * rq, pos0 = samp ? PAST : (t0 + 32 * rq);
        const LAS float* Uc = U + (ubase + 15 + tl0) * 128 + c;
        const float invw = 1.0f / (float)w;
        float wsum = 0.f;
        for (int j = 1; j < w; ++j) wsum += Uc[-j * 128];
        for (int i = 0; i < 32; ++i) {
            const float cur = Uc[i * 128]; wsum += cur;
            const int np = pos0 + i + 1;
            const float d = wsum * (np >= w ? invw : frcp((float)np)) - cur;
            Dm[(32 * rq + i) * 136 + c] = (bf16_t)(pk_bf16(d, 0.f) & 0xffffu);
            wsum -= Uc[(i - (w - 1)) * 128];
        }
    }
    __syncthreads();
    {
        f32x4 acc[8];
#pragma unroll
        for (int nf = 0; nf < 8; ++nf) acc[nf] = (f32x4){0.f, 0.f, 0.f, 0.f};
        asm volatile("" : "+v"(wv[0][0]), "+v"(wv[0][1]), "+v"(wv[0][2]), "+v"(wv[0][3]), "+v"(wv[0][4]), "+v"(wv[0][5]), "+v"(wv[0][6]), "+v"(wv[0][7]),
                     "+v"(wv[1][0]), "+v"(wv[1][1]), "+v"(wv[1][2]), "+v"(wv[1][3]), "+v"(wv[1][4]), "+v"(wv[1][5]), "+v"(wv[1][6]), "+v"(wv[1][7]));
        asm volatile("" : "+v"(wv[2][0]), "+v"(wv[2][1]), "+v"(wv[2][2]), "+v"(wv[2][3]), "+v"(wv[2][4]), "+v"(wv[2][5]), "+v"(wv[2][6]), "+v"(wv[2][7]),
                     "+v"(wv[3][0]), "+v"(wv[3][1]), "+v"(wv[3][2]), "+v"(wv[3][3]), "+v"(wv[3][4]), "+v"(wv[3][5]), "+v"(wv[3][6]), "+v"(wv[3][7]));
#pragma unroll
        for (int ks = 0; ks < 4; ++ks) {
            const bf16x8 av = *(const LAS bf16x8*)(Dm + (16 * wid + fr) * 136 + 32 * ks + 8 * fq);
#pragma unroll
            for (int nf = 0; nf < 8; ++nf) acc[nf] = __builtin_amdgcn_mfma_f32_16x16x32_bf16(wv[ks][nf], av, acc[nf], 0, 0, 0);
        }
        const int row = r0 + 16 * wid + fr;
#pragma unroll
        for (int nf = 0; nf < 8; ++nf) { u32x2 w; w.x = pk_bf16(acc[nf][0], acc[nf][1]); w.y = pk_bf16(acc[nf][2], acc[nf][3]);
            *(u32x2*)(MIX + (size_t)row * DM + 512 + g * 128 + 16 * nf + 4 * fq) = w; }
    }
    __syncthreads();
}

__device__ __forceinline__ void sgu_unit(int chunk, int g, const bf16_t* ZUV, const float* SS2, const float* gn, const bf16_t* SGUW, const float* bs, bf16_t* MIX, LAS unsigned char* lds) {
    const int tid = fresh_tid(), lane = tid & 63, wid = __builtin_amdgcn_readfirstlane(tid >> 6), q32 = lane & 31, hi = lane >> 5;
    LAS bf16_t* ZT = (LAS bf16_t*)lds;
    const int r0 = chunk * 128;
    const int tb = wid & 3, cb0 = (wid >> 2) * 2, t = 32 * tb + q32;
    const int sr = tid & 127, qd = __builtin_amdgcn_readfirstlane(tid >> 7);
    const bf16_t* zp = ZUV + (size_t)(r0 + sr) * 2048 + 1024 + g * 128 + qd * 32;
    const bf16_t* wp = SGUW + (size_t)(g * 128 + t) * 128 + 8 * hi;
    const bf16_t* zup = ZUV + (size_t)(r0 + t) * 2048 + g * 128;
    u32x4 w[4]; f32x4 sq[4]; bf16x8 wvv[8]; u32x2 zav[4], zbv[4];
#pragma unroll
    for (int j = 0; j < 4; ++j) { w[j] = *(const u32x4*)(zp + j * 8); sq[j] = *(const f32x4*)(SS2 + (size_t)(r0 + sr) * 16 + 4 * j); }
#pragma unroll
    for (int ks = 0; ks < 8; ++ks) wvv[ks] = *(const bf16x8*)(wp + 16 * ks);
#pragma unroll
    for (int j = 0; j < 4; ++j) { zav[j] = *(const u32x2*)(zup + 32 * cb0 + 8 * j + 4 * hi); zbv[j] = *(const u32x2*)(zup + 32 * cb0 + 8 * j + 4 * hi + 32); }
    const float bt = bs[g * 128 + t];
    asm volatile("" : "+v"(w[0]), "+v"(w[1]), "+v"(w[2]), "+v"(w[3]), "+v"(sq[0]), "+v"(sq[1]), "+v"(sq[2]), "+v"(sq[3]),
                 "+v"(wvv[0]), "+v"(wvv[1]), "+v"(wvv[2]), "+v"(wvv[3]), "+v"(wvv[4]), "+v"(wvv[5]), "+v"(wvv[6]), "+v"(wvv[7]),
                 "+v"(zav[0]), "+v"(zav[1]), "+v"(zav[2]), "+v"(zav[3]), "+v"(zbv[0]), "+v"(zbv[1]), "+v"(zbv[2]), "+v"(zbv[3]) :: "memory");
    {
        const float sm = ((sq[0].x + sq[0].y) + (sq[0].z + sq[0].w)) + ((sq[1].x + sq[1].y) + (sq[1].z + sq[1].w)) + ((sq[2].x + sq[2].y) + (sq[2].z + sq[2].w)) + ((sq[3].x + sq[3].y) + (sq[3].z + sq[3].w));
        const float rs = rsqrtf(sm * (1.0f / 1024.0f) + EPS);
#pragma unroll
        for (int j = 0; j < 4; ++j) {
            const float* gp = gn + g * 128 + qd * 32 + j * 8; const f32x4 g0 = *(const f32x4*)gp, g1 = *(const f32x4*)(gp + 4);
            const float v[8] = {bf_lo(w[j].x) * rs * g0.x, bf_hi(w[j].x) * rs * g0.y, bf_lo(w[j].y) * rs * g0.z, bf_hi(w[j].y) * rs * g0.w, bf_lo(w[j].z) * rs * g1.x, bf_hi(w[j].z) * rs * g1.y, bf_lo(w[j].w) * rs * g1.z, bf_hi(w[j].w) * rs * g1.w};
            LAS bf16_t* zt = ZT + (qd * 32 + j * 8) * 136 + sr;
#pragma unroll
            for (int e = 0; e < 8; ++e) zt[e * 136] = (bf16_t)(pk_bf16(v[e], 0.f) & 0xffffu);
        }
    }
    __syncthreads();
    f32x16 d0, d1;
#pragma unroll
    for (int r = 0; r < 16; ++r) { d0[r] = 0.f; d1[r] = 0.f; }
#pragma unroll
    for (int ks = 0; ks < 8; ++ks) {
        const bf16x8 z0 = *(const LAS bf16x8*)(ZT + (32 * cb0 + q32) * 136 + 16 * ks + 8 * hi);
        const bf16x8 z1 = *(const LAS bf16x8*)(ZT + (32 * (cb0 + 1) + q32) * 136 + 16 * ks + 8 * hi);
        d0 = __builtin_amdgcn_mfma_f32_32x32x16_bf16(z0, wvv[ks], d0, 0, 0, 0);
        d1 = __builtin_amdgcn_mfma_f32_32x32x16_bf16(z1, wvv[ks], d1, 0, 0, 0);
    }
    bf16_t* op = MIX + (size_t)(r0 + t) * DM + g * 128;
#pragma unroll
    for (int j = 0; j < 4; ++j) {
        const int c0 = 32 * cb0 + 8 * j + 4 * hi, c1 = c0 + 32;
        const u32x2 za = zav[j], zb = zbv[j];
        u32x2 wa, wb;
        wa.x = pk_bf16(bf_lo(za.x) * (d0[4 * j + 0] + bt), bf_hi(za.x) * (d0[4 * j + 1] + bt)); wa.y = pk_bf16(bf_lo(za.y) * (d0[4 * j + 2] + bt), bf_hi(za.y) * (d0[4 * j + 3] + bt));
        wb.x = pk_bf16(bf_lo(zb.x) * (d1[4 * j + 0] + bt), bf_hi(zb.x) * (d1[4 * j + 1] + bt)); wb.y = pk_bf16(bf_lo(zb.y) * (d1[4 * j + 2] + bt), bf_hi(zb.y) * (d1[4 * j + 3] + bt));
        *(u32x2*)(op + c0) = wa; *(u32x2*)(op + c1) = wb;
    }
    __syncthreads();
}
__device__ __forceinline__ void sgu_sample_unit(int b, int g, const bf16_t* ZUV, const float* SS2, const float* gn, const float* ws_f32, const float* bs, bf16_t* MIX, float* zs_out, LAS unsigned char* lds) {
    const int tid = fresh_tid();
    LAS float* Z = (LAS float*)lds; LAS float* rsl = (LAS float*)(lds + 16384);
    const int R0 = MP + b * 32;
    if (tid < 32) rsl[tid] = row_rstd(SS2, R0 + tid);
    __syncthreads();
    { const int s = tid >> 4, ch = tid & 15; const float rs = rsl[s];
      const u32x4 w = *(const u32x4*)(ZUV + (size_t)(R0 + s) * 2048 + 1024 + g * 128 + ch * 8);
      const f32x4 g0 = *(const f32x4*)(gn + g * 128 + ch * 8), g1 = *(const f32x4*)(gn + g * 128 + ch * 8 + 4);
      const f32x4 lo = (f32x4){bf_lo(w.x) * rs * g0.x, bf_hi(w.x) * rs * g0.y, bf_lo(w.y) * rs * g0.z, bf_hi(w.y) * rs * g0.w};
      const f32x4 hi4 = (f32x4){bf_lo(w.z) * rs * g1.x, bf_hi(w.z) * rs * g1.y, bf_lo(w.w) * rs * g1.z, bf_hi(w.w) * rs * g1.w};
      *(LAS f32x4*)(Z + s * 128 + ch * 8) = lo; *(LAS f32x4*)(Z + s * 128 + ch * 8 + 4) = hi4;
      float* zo = zs_out + (size_t)(b * 32 + s) * 1024 + g * 128 + ch * 8; *(f32x4*)zo = lo; *(f32x4*)(zo + 4) = hi4; }
    __syncthreads();
    { const int c = tid & 127, tq = tid >> 7;
      for (int ti = 0; ti < 8; ++ti) { const int t = tq * 8 + ti; float acc = bs[g * 128 + t]; const float* wrow = ws_f32 + (size_t)(g * 128 + t) * 128;
#pragma unroll 8
          for (int s = 0; s < 32; ++s) acc += wrow[s] * Z[s * 128 + c];
          const float zu = bf_lo((unsigned)ZUV[(size_t)(R0 + t) * 2048 + g * 128 + c]);
          MIX[(size_t)(R0 + t) * DM + g * 128 + c] = (bf16_t)(pk_bf16(zu * acc, 0.f) & 0xffffu); } }
    __syncthreads();
}

__device__ __forceinline__ void sres_phase(const bf16_t* A, const bf16_t* Bt, int K, const float* baseS, bf16_t* XB, float* SS, float alpha, int f32base, LAS unsigned char* lds) {
    const int tid = fresh_tid(), lane = tid & 63, wid = __builtin_amdgcn_readfirstlane(tid >> 6), fr = lane & 15, fq = lane >> 4;
    const int kh = wid >> 2, w4 = wid & 3, Kh = K >> 1;
    for (int blk = blockIdx.x; blk < 256; blk += gridDim.x) {
        const int cg = blk & 15, rs = ((blk >> 4) << 2) + w4;
        const int row = MP + rs * 16 + fr;
        const bf16_t* ap = A + (size_t)row * K + kh * Kh + fq * 8;
        const bf16_t* bp = Bt + (size_t)(cg * 64 + fr) * K + kh * Kh + fq * 8;
        f32x4 acc[4];
#pragma unroll
        for (int nf = 0; nf < 4; ++nf) acc[nf] = (f32x4){0.f, 0.f, 0.f, 0.f};
#pragma unroll 1
        for (int k0 = 0; k0 < Kh; k0 += 128) {
            bf16x8 av[4], bv[4][4];
#pragma unroll
            for (int uu = 0; uu < 4; ++uu) { av[uu] = *(const bf16x8*)(ap + k0 + uu * 32);
#pragma unroll
                for (int nf = 0; nf < 4; ++nf) bv[uu][nf] = *(const bf16x8*)(bp + (size_t)nf * 16 * K + k0 + uu * 32); }
            asm volatile("" : "+v"(av[0]), "+v"(av[1]), "+v"(av[2]), "+v"(av[3]),
                         "+v"(bv[0][0]), "+v"(bv[0][1]), "+v"(bv[0][2]), "+v"(bv[0][3]), "+v"(bv[1][0]), "+v"(bv[1][1]), "+v"(bv[1][2]), "+v"(bv[1][3]),
                         "+v"(bv[2][0]), "+v"(bv[2][1]), "+v"(bv[2][2]), "+v"(bv[2][3]), "+v"(bv[3][0]), "+v"(bv[3][1]), "+v"(bv[3][2]), "+v"(bv[3][3]) :: "memory");
#pragma unroll
            for (int uu = 0; uu < 4; ++uu)
#pragma unroll
                for (int nf = 0; nf < 4; ++nf) acc[nf] = __builtin_amdgcn_mfma_f32_16x16x32_bf16(bv[uu][nf], av[uu], acc[nf], 0, 0, 0);
        }
        LAS f32x4* red = (LAS f32x4*)lds + (w4 * 4) * 64 + lane;
        if (kh == 1) {
#pragma unroll
            for (int nf = 0; nf < 4; ++nf) red[nf * 64] = acc[nf];
        }
        __syncthreads();
        if (kh == 0) {
            float ss = 0.f;
#pragma unroll
            for (int nf = 0; nf < 4; ++nf) {
                const f32x4 a2 = acc[nf] + red[nf * 64];
                const int col = cg * 64 + nf * 16 + 4 * fq; bf16_t* xp = XB + (size_t)row * DM + col; f32x4 b;
                if (f32base) b = *(const f32x4*)(baseS + (size_t)(row - MP) * DM + col);
                else { const u32x2 w = *(const u32x2*)xp; b = (f32x4){bf_lo(w.x), bf_hi(w.x), bf_lo(w.y), bf_hi(w.y)}; }
                const f32x4 x = b + a2 * alpha;
                u32x2 w; w.x = pk_bf16(x[0], x[1]); w.y = pk_bf16(x[2], x[3]); *(u32x2*)xp = w;
                ss += (x[0] * x[0] + x[1] * x[1]) + (x[2] * x[2] + x[3] * x[3]);
            }
            ss += __shfl_xor(ss, 16); ss += __shfl_xor(ss, 32);
            if (fq == 0) SS[(size_t)row * 16 + cg] = ss;
        }
        __syncthreads();
    }
}

#define XB_TMO      128
#define XB_XCNT(j)  (256  + 64 * (j))
#define XB_XSUB(j)  (1280 + 64 * (j))
#define XB_XGEN(j)  (2304 + 64 * (j))
#define XB_TOP      3328
#define XB_TOPGEN   3392
#define XCD_BAR_WORDS 3456
#define XB_SPIN_CAP (1u << 22)
__device__ __forceinline__ unsigned xb_ld(unsigned* p)              { return __hip_atomic_load(p, __ATOMIC_RELAXED, __HIP_MEMORY_SCOPE_AGENT); }
__device__ __forceinline__ unsigned xb_add(unsigned* p, unsigned v) { return __hip_atomic_fetch_add(p, v, __ATOMIC_RELAXED, __HIP_MEMORY_SCOPE_AGENT); }
__device__ __forceinline__ unsigned xb_xcc_id() { return (unsigned)__builtin_amdgcn_s_getreg((3 << 11) | 20) & 0xFu; }
#define XB_SPIN(cond, bar) do { unsigned _sp = 0; while (cond) { __builtin_amdgcn_s_sleep(1); \
    if ((++_sp & 255u) == 0u) { if (xb_ld(&(bar)[XB_TMO])) break; if (_sp > XB_SPIN_CAP) { atomicAdd(&(bar)[XB_TMO], 1u); break; } } } } while (0)
constexpr int LDS_XB = LDS_BYTES - 64;
__device__ __forceinline__ void xcd_barrier_complete(unsigned* bar, unsigned x, unsigned& nloc, unsigned& nx) {
    const unsigned G = gridDim.x * gridDim.y * gridDim.z;
    unsigned sum, cnt, mine, sp = 0u;
    for (;;) {
        sum = 0u; cnt = 0u; mine = 0u;
#pragma unroll
        for (unsigned j = 0; j < 16; ++j) { const unsigned c = xb_ld(&bar[XB_XCNT(j)]); sum += c; cnt += (c > 0u) ? 1u : 0u; mine = (j == x) ? c : mine; }
        if (sum == G) break;
        __builtin_amdgcn_s_sleep(1);
        if ((++sp & 255u) == 0u) { if (xb_ld(&bar[XB_TMO])) break; if (sp > XB_SPIN_CAP) { atomicAdd(&bar[XB_TMO], 1u); break; } }
    }
    nloc = mine > 0u ? mine : 1u; nx = cnt > 0u ? cnt : 1u;
}
__device__ __forceinline__ void gsync(unsigned* bar, LAS unsigned char* lds) {
    asm volatile("s_waitcnt vmcnt(0) lgkmcnt(0)" ::: "memory");
    __syncthreads();
    if (threadIdx.x == 0) {
        volatile LAS unsigned* st = (volatile LAS unsigned*)(lds + LDS_XB);
        __builtin_amdgcn_s_waitcnt(0);
        unsigned nloc = st[0], nx = st[1]; const unsigned x = st[2];
        if (nloc == 0u) { xcd_barrier_complete(bar, x, nloc, nx); st[0] = nloc; st[1] = nx; }
        const unsigned old = xb_add(&bar[XB_XSUB(x)], 1u);
        const unsigned gen = old / nloc;
        if (old + 1u == (gen + 1u) * nloc) {
            __builtin_amdgcn_fence(__ATOMIC_RELEASE, "agent");
            asm volatile("s_waitcnt vmcnt(0)" ::: "memory");
            const unsigned og = xb_add(&bar[XB_TOP], 1u);
            const unsigned tg = og / nx;
            if (og + 1u == (tg + 1u) * nx) xb_add(&bar[XB_TOPGEN], 1u);
            else XB_SPIN(xb_ld(&bar[XB_TOPGEN]) == tg, bar);
            __builtin_amdgcn_fence(__ATOMIC_ACQUIRE, "agent");
            xb_add(&bar[XB_XGEN(x)], 1u);
            asm volatile("s_waitcnt vmcnt(0)" ::: "memory");
        } else {
            XB_SPIN(xb_ld(&bar[XB_XGEN(x)]) == gen, bar);
            __builtin_amdgcn_fence(__ATOMIC_ACQUIRE, "agent");
            asm volatile("s_waitcnt vmcnt(0)" ::: "memory");
        }
    }
    __syncthreads();
}

__global__ void __launch_bounds__(512) fwd_megakernel(Args a) {
    extern __shared__ __attribute__((aligned(16))) unsigned char lds_raw[];
    LAS unsigned char* lds = (LAS unsigned char*)lds_raw;
    cg::grid_group grid = cg::this_grid();
    const int G = gridDim.x, bx = blockIdx.x;
    unsigned char* ws = a.ws; float* out = a.out;
    bf16_t* W1 = (bf16_t*)(ws + WS_W1); bf16_t* W2 = (bf16_t*)(ws + WS_W2);
    bf16_t* XB = (bf16_t*)(ws + WS_XB); bf16_t* MIX = (bf16_t*)(ws + WS_MIX); bf16_t* R1 = (bf16_t*)(ws + WS_R1);
    float* SS = (float*)(ws + WS_SS); float* SS2 = (float*)(ws + WS_SS2);
    float* X = out + OFF_Y;

    unsigned* bar = (unsigned*)(ws + WS_BAR);
    if (threadIdx.x == 0) { volatile LAS unsigned* st = (volatile LAS unsigned*)(lds + LDS_XB); const unsigned x = xb_xcc_id(); st[0] = 0u; st[1] = 0u; st[2] = x; (void)xb_add(&bar[XB_XCNT(x)], 1u); }
    grid.sync();
    p0_phase(a, lds);
    gsync(bar, lds);

    for (int s = 0; s < 4; ++s) {
        const int l = s >> 1, j = s & 1;
        if (j == 1) {
            if (l == 0) {
                { pg8::Gemm g{XB, (const bf16_t*)(ws + WS_WEIN), MT, 2048, DM}; pg8::StaticOrder S; S.init(MT, 2048, G, bx);
                  pg8::EpiProjEven E{R1, SS, out};
                  pg8::gemm_phase<pg8::EpiProjEven, pg8::StaticOrder, true, true>(lds, g, S, E); }
                for (int i = (G == 256 ? bx - 32 : bx + G); i >= 0 && i < MT / 256; i += (G == 256 ? 224 : G)) f_unit(i, XB, (const bf16_t*)(ws + WS_WF), SS, a.in[10], out);
                gsync(bar, lds);
                for (int bh = bx; bh < 256; bh += G) {
                    const int b = bh >> 3, h = bh & 7;
                    { const float* lf = out + OFF_FP + (size_t)b * SEQ * 8 + h; const int t = 4 * fresh_tid();
                      scan2048(lf[(size_t)(t + 0) * 8], lf[(size_t)(t + 1) * 8], lf[(size_t)(t + 2) * 8], lf[(size_t)(t + 3) * 8], lds); }
                    for (int qb = 7; qb >= 0; --qb) {
                        AttnJob J; J.Qrow0 = R1 + (size_t)(b * SEQ + qb * 256) * 2048 + h * 64; J.Orow0 = MIX + (size_t)(b * SEQ + qb * 256) * DM + h * 64;
                        J.nqw = 8; J.qpos0 = qb * 256; J.NT = 4 * (qb + 1); J.mode = 0; J.Kb = R1 + (size_t)(b * SEQ) * 2048 + 512 + h * 64; J.cK = nullptr; J.cV = nullptr;
                        attn_unit(J, lds);
                    }
                }
                for (int bh = bx; bh < 256; bh += G) {
                    const int b = bh >> 3, h = bh & 7;
                    { const float* cf = a.in[4] + (size_t)b * PAST * 8 + h; const float* nf = out + OFF_FS + (size_t)b * TS * 8 + h; float v[4]; const int tid = fresh_tid();
#pragma unroll
                      for (int e = 0; e < 4; ++e) { const int t = 4 * tid + e; v[e] = t < PAST ? cf[(size_t)t * 8] : (t < PAST + TS ? nf[(size_t)(t - PAST) * 8] : 0.f); }
                      scan2048(v[0], v[1], v[2], v[3], lds); }
                    AttnJob J; J.Qrow0 = R1 + (size_t)(MP + b * TS) * 2048 + h * 64; J.Orow0 = MIX + (size_t)(MP + b * TS) * DM + h * 64;
                    J.nqw = 1; J.qpos0 = PAST; J.NT = 17; J.mode = 1; J.Kb = R1 + (size_t)(MP + b * TS) * 2048 + 512 + h * 64;
                    J.cK = a.in[2] + (size_t)b * PAST * 512 + h * 64; J.cV = a.in[3] + (size_t)b * PAST * 512 + h * 64;
                    attn_unit(J, lds);
                }
                for (int u = bx; u < 520 * 4; u += G) pool_unit(u >> 2, u & 3, R1, a.in[5], (const bf16_t*)(ws + WS_POOLWT), MIX, lds);
                gsync(bar, lds);
                { pg8::Gemm g{MIX, (const bf16_t*)(ws + WS_WEOUT), MP, DM, DM}; pg8::StaticOrder S; S.init(MP, DM, G, bx);
                  pg8::EpiResidual E{nullptr, nullptr, XB, SS, 1.0f, 0};
                  pg8::gemm_phase<pg8::EpiResidual, pg8::StaticOrder, true, true>(lds, g, S, E); }
                sres_phase(MIX, (const bf16_t*)(ws + WS_WEOUT), DM, nullptr, XB, SS, 1.0f, 0, lds);
                gsync(bar, lds);
            } else {
                { pg8::Gemm g{XB, (const bf16_t*)(ws + WS_WSIN), MT, 2048, DM}; pg8::StaticOrder S; S.init(MT, 2048, G, bx);
                  pg8::EpiSguProj E{R1, SS, SS2};
                  pg8::gemm_phase<pg8::EpiSguProj, pg8::StaticOrder, true, true>(lds, g, S, E); }
                gsync(bar, lds);
                for (int u = bx; u < 512 * 8; u += G) sgu_unit(511 - (u >> 3), u & 7, R1, SS2, a.in[15], (const bf16_t*)(ws + WS_SGUW), a.in[17], MIX, lds);
                for (int u = bx; u < 32 * 8; u += G) sgu_sample_unit(u >> 3, u & 7, R1, SS2, a.in[15], a.in[16], a.in[17], MIX, out + OFF_ZS, lds);
                gsync(bar, lds);
                { pg8::Gemm g{MIX, (const bf16_t*)(ws + WS_WSOUT), MP, DM, DM}; pg8::StaticOrder S; S.init(MP, DM, G, bx);
                  pg8::EpiResidual E{nullptr, nullptr, XB, SS, 1.0f, 0};
                  pg8::gemm_phase<pg8::EpiResidual, pg8::StaticOrder, true, true>(lds, g, S, E); }
                sres_phase(MIX, (const bf16_t*)(ws + WS_WSOUT), DM, nullptr, XB, SS, 1.0f, 0, lds);
                gsync(bar, lds);
            }
        }
        { pg8::Gemm g{XB, W1 + (size_t)s * NFF * DM, MT, NFF, DM}; pg8::StaticOrder S; S.init(MT, NFF, G, bx);
          pg8::EpiSwiGLU E{R1, SS};
          pg8::gemm_phase<pg8::EpiSwiGLU, pg8::StaticOrder, true, true>(lds, g, S, E); }
        if (s == 0 && G == 256 && bx >= 88)
            p0_weight_items(a, lds, 1, 2, (bx - 88) * 8 + __builtin_amdgcn_readfirstlane(fresh_tid() >> 6), 168 * 8);
        gsync(bar, lds);
        { pg8::Gemm g{R1, W2 + (size_t)s * DM * DFF, MP, DM, DFF}; pg8::StaticOrder S; S.init(MP, DM, G, bx); S.rev = 1;
          pg8::EpiResidual E{a.in[0], a.in[1], XB, SS, 0.5f, s == 0 ? 1 : 0};
          pg8::gemm_phase<pg8::EpiResidual, pg8::StaticOrder, true, true>(lds, g, S, E); }
        sres_phase(R1, W2 + (size_t)s * DM * DFF, DFF, a.in[1], XB, SS, 0.5f, s == 0 ? 1 : 0, lds);
        gsync(bar, lds);
    }
    {
        const int tid = fresh_tid(), lane = tid & 63, wid = __builtin_amdgcn_readfirstlane(tid >> 6);
        const int gw = bx * 8 + wid, NGW = G * 8; const float* fg = a.in[19];
        f32x4 gv[4];
#pragma unroll
        for (int jx = 0; jx < 4; ++jx) gv[jx] = *(const f32x4*)(fg + (lane + 64 * jx) * 4);
        for (int row0 = gw; row0 < MT; row0 += 4 * NGW) {
            u32x2 w[4][4];
#pragma unroll
            for (int i = 0; i < 4; ++i) { const int row = min(row0 + i * NGW, MT - 1);
#pragma unroll
                for (int jx = 0; jx < 4; ++jx) w[i][jx] = *(const u32x2*)(XB + (size_t)row * DM + (lane + 64 * jx) * 4); }
            asm volatile("" : "+v"(w[0][0]), "+v"(w[0][1]), "+v"(w[0][2]), "+v"(w[0][3]), "+v"(w[1][0]), "+v"(w[1][1]), "+v"(w[1][2]), "+v"(w[1][3]),
                         "+v"(w[2][0]), "+v"(w[2][1]), "+v"(w[2][2]), "+v"(w[2][3]), "+v"(w[3][0]), "+v"(w[3][1]), "+v"(w[3][2]), "+v"(w[3][3]) :: "memory");
#pragma unroll
            for (int i = 0; i < 4; ++i) { const int row = row0 + i * NGW; if (row < MT) { f32x4 v[4]; float ss = 0.f;
#pragma unroll
                for (int jx = 0; jx < 4; ++jx) { v[jx] = (f32x4){bf_lo(w[i][jx].x), bf_hi(w[i][jx].x), bf_lo(w[i][jx].y), bf_hi(w[i][jx].y)};
                    ss += (v[jx].x * v[jx].x + v[jx].y * v[jx].y) + (v[jx].z * v[jx].z + v[jx].w * v[jx].w); }
                ss = wave_sum(ss); const float r = rsqrtf(ss * (1.0f / 1024.0f) + EPS); float* yr = X + (size_t)row * DM;
#pragma unroll
                for (int jx = 0; jx < 4; ++jx) __builtin_nontemporal_store(v[jx] * r * gv[jx], (f32x4*)(yr + (lane + 64 * jx) * 4)); } }
        }
    }
}

extern "C" void kernel_launch(void* const* d_in, const int* in_sizes, int n_in, void* d_out, int out_size, void* d_ws, size_t ws_size, hipStream_t stream) {
    static int grid = 0;
    if (grid == 0) {
        if (n_in != 20 || ws_size < WS_END) { fprintf(stderr, "kernel_launch: unexpected inputs (n_in %d, ws %zu, need %zu)\n", n_in, ws_size, (size_t)WS_END); grid = -1; return; }
        int dev = 0, cus = 0, per_cu = 0;
        hipGetDevice(&dev);
        hipDeviceGetAttribute(&cus, hipDeviceAttributeMultiprocessorCount, dev);
        if (hipFuncSetAttribute((const void*)fwd_megakernel, hipFuncAttributeMaxDynamicSharedMemorySize, LDS_BYTES) != hipSuccess) { fprintf(stderr, "kernel_launch: hipFuncSetAttribute failed\n"); grid = -1; return; }
        if (hipOccupancyMaxActiveBlocksPerMultiprocessor(&per_cu, (const void*)fwd_megakernel, 512, LDS_BYTES) != hipSuccess || per_cu < 1) { fprintf(stderr, "kernel_launch: occupancy query gives %d\n", per_cu); per_cu = 1; }
        (void)hipGetLastError();
        grid = cus * per_cu;
    }
    if (grid < 0) return;
    if (hipMemsetAsync((char*)d_ws + WS_BAR, 0, 16384, stream) != hipSuccess) { fprintf(stderr, "kernel_launch: memset failed\n"); return; }
    Args a{};
    for (int i = 0; i < 20; ++i) a.in[i] = (const float*)d_in[i];
    a.out = (float*)d_out; a.ws = (unsigned char*)d_ws;
    void* args[] = {&a};
    hipError_t e = hipLaunchCooperativeKernel((const void*)fwd_megakernel, dim3(grid), dim3(512), args, LDS_BYTES, stream);
    if (e != hipSuccess) fprintf(stderr, "cooperative launch failed: %s (grid %d)\n", hipGetErrorString(e), grid);
}
```

```cpp
#include <hip/hip_runtime.h>
#include <hip/hip_cooperative_groups.h>
#include <cstdio>
#include <cstdint>
namespace cg = cooperative_groups;

#define LAS __attribute__((address_space(3)))
typedef unsigned short bf16_t;
typedef short bf16x8 __attribute__((ext_vector_type(8)));
typedef float f32x4 __attribute__((ext_vector_type(4)));
typedef float f32x16 __attribute__((ext_vector_type(16)));
typedef unsigned u32x4 __attribute__((ext_vector_type(4)));
typedef unsigned u32x2 __attribute__((ext_vector_type(2)));

constexpr int DM = 1024, MP = 65536, MS = 1024, MT = MP + MS, DFF = 2816, NFF = 5632;
constexpr int SEQ = 2048, TS = 32, PAST = 1024;
constexpr float EPS = 1e-6f, LOG2E = 1.4426950408889634f, QSCALE = 0.125f * 1.4426950408889634f;
constexpr size_t OFF_Y = 0, OFF_KP = 68157440, OFF_VP = 101711872, OFF_FP = 135266304, OFF_PP = 135790592,
                 OFF_KS = 136036352, OFF_VS = 136560640, OFF_FS = 137084928, OFF_PS = 137093120, OFF_ZS = 137338880;
constexpr size_t WS_W1 = 0;
constexpr size_t WS_W2 = WS_W1 + (size_t)4 * NFF * DM * 2;
constexpr size_t WS_WEIN = WS_W2 + (size_t)4 * DM * DFF * 2;
constexpr size_t WS_WF = WS_WEIN + (size_t)2048 * DM * 2;
constexpr size_t WS_WEOUT = WS_WF + (size_t)16 * DM * 2;
constexpr size_t WS_WSIN = WS_WEOUT + (size_t)DM * DM * 2;
constexpr size_t WS_WSOUT = WS_WSIN + (size_t)2048 * DM * 2;
constexpr size_t WS_POOLWT = WS_WSOUT + (size_t)DM * DM * 2;
constexpr size_t WS_SGUW = WS_POOLWT + (size_t)4 * 128 * 128 * 2;
constexpr size_t WS_SS = WS_SGUW + (size_t)8 * 128 * 128 * 2;
constexpr size_t WS_SS2 = WS_SS + (size_t)MT * 16 * 4;
constexpr size_t WS_XB = WS_SS2 + (size_t)MT * 16 * 4;
constexpr size_t WS_MIX = WS_XB + (size_t)MT * DM * 2;
constexpr size_t WS_R1 = WS_MIX + (size_t)MT * DM * 2;
constexpr size_t WS_BAR = WS_R1 + (size_t)MT * DFF * 2;
constexpr size_t WS_END = WS_BAR + 16384;
constexpr int LDS_BYTES = 147456;

struct Args {
    const float* in[20];
    float* out;
    unsigned char* ws;
};

typedef float f32x2_t __attribute__((ext_vector_type(2))); typedef __bf16 bf16x2_t __attribute__((ext_vector_type(2)));
__device__ __forceinline__ unsigned pk_bf16(float lo, float hi) { const f32x2_t v = {lo, hi}; const bf16x2_t b = __builtin_convertvector(v, bf16x2_t); return __builtin_bit_cast(unsigned, b); }
__device__ __forceinline__ int fresh_tid() { int t = threadIdx.x; asm volatile("" : "+v"(t)); return t; }
__device__ __forceinline__ float bf_lo(unsigned w) { return __uint_as_float(w << 16); }
__device__ __forceinline__ float bf_hi(unsigned w) { return __uint_as_float(w & 0xffff0000u); }
__device__ __forceinline__ float fexp2(float x) { return __builtin_amdgcn_exp2f(x); }
__device__ __forceinline__ float frcp(float x) { return __builtin_amdgcn_rcpf(x); }
__device__ __forceinline__ float wave_sum(float v) {
#pragma unroll
    for (int o = 1; o < 64; o <<= 1) v += __shfl_xor(v, o);
    return v;
}
__device__ __forceinline__ float row_rstd(const float* SS, int row) {
    const f32x4* p = (const f32x4*)(SS + (size_t)row * 16);
    const f32x4 a = p[0], b = p[1], c = p[2], d = p[3];
    const float s = ((a.x + a.y) + (a.z + a.w)) + ((b.x + b.y) + (b.z + b.w)) + ((c.x + c.y) + (c.z + c.w)) + ((d.x + d.y) + (d.z + d.w));
    return rsqrtf(s * (1.0f / 1024.0f) + EPS);
}
typedef float f32x2 __attribute__((ext_vector_type(2)));
__device__ __forceinline__ f32x2 swiglu2(f32x2 g, f32x2 u, float k1, float rs2) {
    const f32x2 a = g * k1; f32x2 e; e.x = fexp2(a.x); e.y = fexp2(a.y);
    const f32x2 d = e + 1.0f; f32x2 r; r.x = frcp(d.x); r.y = frcp(d.y);
    return (g * u) * (r * rs2);
}
__device__ __forceinline__ f32x2 gelu2(f32x2 x) {
    const f32x2 p = (x * x) * 0.044715f + 1.0f; const f32x2 a = (x * p) * (-LOG2E * 1.5957691216057308f);
    f32x2 e; e.x = fexp2(a.x); e.y = fexp2(a.y); const f32x2 d = e + 1.0f; f32x2 r; r.x = frcp(d.x); r.y = frcp(d.y);
    return x * r;
}
__device__ __forceinline__ float silu_mul(float g, float u) { return g * frcp(1.0f + fexp2(-LOG2E * g)) * u; }
__device__ __forceinline__ float gelu_tanh(float x) { const float t = x + 0.044715f * x * x * x; return x * frcp(1.0f + fexp2(-LOG2E * 1.5957691216057308f * t)); }

namespace pg8 {
#define PG8_LAS __attribute__((address_space(3)))
constexpr int BM = 256, BK = 64, HALF = 128, HTB = HALF * BK * 2, STAGE_BYTES = 8 * HTB, NXCD = 8, WGM = 8;
__host__ __device__ __forceinline__ int lds_byte(int r, int c) { const int st = (r >> 4) * 2 + (c >> 5), rr = r & 15, cc = c & 31, ob = rr * 64 + cc * 2; return st * 1024 + (ob ^ (((ob >> 9) & 1) << 5)); }
__host__ __device__ __forceinline__ void stage_rc(int b, int& R, int& C) { const int st = b / 1024, sb = b % 1024, swz = sb ^ (((sb >> 9) & 1) << 5); R = (st >> 1) * 16 + swz / 64; C = (st & 1) * 32 + (swz % 64) / 2; }
__host__ __device__ __forceinline__ int perm32(int rho) { const int n = rho >> 4, i = rho & 15; return 8 * (i >> 2) + 4 * n + (i & 3); }
struct Unit { int pm, pn; };
struct Gemm { const bf16_t* A; const bf16_t* Bt; int M, N, K; };
struct StaticOrder {
    int nM, nN, nwg, G, c, rev;
    __host__ __device__ void init(int M, int N, int G_, int c_) { nM = M / BM; nN = N / BM; nwg = nM * nN; G = G_; c = c_; rev = 0; }
    __host__ __device__ bool next(int i, Unit& u) const {
        const long L = (long)i * G + c; if (L >= nwg) return false;
        int wgid = (int)L; { const int q = nwg / NXCD, r = nwg % NXCD, xcd = wgid % NXCD, off = wgid / NXCD; wgid = (xcd < r ? xcd * (q + 1) : r * (q + 1) + (xcd - r) * q) + off; }
        const int nig = WGM * nN, gid = wgid / nig, fm = gid * WGM, gsz = (nM - fm) < WGM ? (nM - fm) : WGM;
        u.pm = fm + ((wgid % nig) % gsz); u.pn = (wgid % nig) / gsz; if (rev) u.pm = nM - 1 - u.pm; return true;
    }
    __device__ __forceinline__ void a_ready(const Unit&) const {}
    __device__ __forceinline__ void done(const Unit&) const {}
};
template <class Epi, class Sched, bool ALIGN_EPI = false, bool SP2 = false>
__device__ __forceinline__ void gemm_phase(PG8_LAS unsigned char* lds, const Gemm g, const Sched& S, const Epi& E) {
    const int tid = fresh_tid(), wid = __builtin_amdgcn_readfirstlane(tid >> 6), lane = tid & 63, wr = wid >> 2, wc = wid & 3, fr = lane & 15, fq = lane >> 4;
    const int K = g.K, nt = K / BK;
    unsigned voffA[2], voffB[2];
#pragma unroll
    for (int i = 0; i < 2; ++i) { int R, C; stage_rc(tid * 16 + i * 8192, R, C); const int Rb = Epi::PERM ? ((R & ~31) + perm32(R & 31)) : R;
        voffA[i] = (unsigned)(R * K + C) * 2u; voffB[i] = (unsigned)(Rb * K + C) * 2u; }
    const size_t kstep = (size_t)(BK * 2);
    const size_t hstep = (size_t)HALF * K * 2;
    const size_t tstep = 2 * hstep;
    const unsigned ldsw = (unsigned)wid * 1024u;
    const int aoff = lds_byte(wr * 64 + fr, fq * 8), boff = lds_byte(wc * 32 + fr, fq * 8);
#define PG8_SA(b, h) (((b) * 2 + (h)) * HTB)
#define PG8_SB(b, h) ((4 + (b) * 2 + (h)) * HTB)
#define PG8_STAGE(bufoff, gbase, voff) do { _Pragma("unroll") for (int _i = 0; _i < 2; ++_i) \
        __builtin_amdgcn_global_load_lds((const unsigned*)((const char*)(gbase) + (voff)[_i]), (PG8_LAS unsigned*)(lds + (bufoff) + ldsw + _i * 8192), 16, 0, 0); } while (0)
#define PG8_LDA(dst, b, h) do { _Pragma("unroll") for (int m = 0; m < 4; ++m) _Pragma("unroll") for (int k = 0; k < 2; ++k) dst[m][k] = *(const PG8_LAS bf16x8*)(lds + PG8_SA(b, h) + aoff + m * 2048 + k * 1024); } while (0)
#define PG8_LDB(dst, b, h) do { _Pragma("unroll") for (int n = 0; n < 2; ++n) _Pragma("unroll") for (int k = 0; k < 2; ++k) dst[n][k] = *(const PG8_LAS bf16x8*)(lds + PG8_SB(b, h) + boff + n * 2048 + k * 1024); } while (0)
#define PG8_MMA(ai, bj, At, Bt) do { __builtin_amdgcn_s_setprio(1); _Pragma("unroll") for (int m = 0; m < 4; ++m) _Pragma("unroll") for (int n = 0; n < 2; ++n) _Pragma("unroll") for (int k = 0; k < 2; ++k) \
        acc[ai][bj][m][n] = __builtin_amdgcn_mfma_f32_16x16x32_bf16(Bt[n][k], At[m][k], acc[ai][bj][m][n], 0, 0, 0); __builtin_amdgcn_s_setprio(0); } while (0)
#define PG8_WAIT_V(n) asm volatile("s_waitcnt vmcnt(" #n ")" ::: "memory")
#define PG8_WAIT_L(n) asm volatile("s_waitcnt lgkmcnt(" #n ")" ::: "memory")
#define PG8_BAR __builtin_amdgcn_s_barrier()
#define PG8_SCHED __builtin_amdgcn_sched_barrier(0)
    PG8_LAS float* rsl = (PG8_LAS float*)(lds + STAGE_BYTES);
    f32x4 rq0, rq1, rq2, rq3;
#define PG8_RS_ISSUE(U) do { if (Epi::RS && tid < 256) { const f32x4* _p = (const f32x4*)(E.SS + (size_t)((U).pm * BM + tid) * 16); rq0 = _p[0]; rq1 = _p[1]; rq2 = _p[2]; rq3 = _p[3]; } } while (0)
#define PG8_RS_COMMIT(PAR) do { if (Epi::RS && tid < 256) { const float _s = (((rq0.x + rq0.y) + (rq0.z + rq0.w)) + ((rq1.x + rq1.y) + (rq1.z + rq1.w))) + (((rq2.x + rq2.y) + (rq2.z + rq2.w)) + ((rq3.x + rq3.y) + (rq3.z + rq3.w))); \
        rsl[(PAR) * 256 + tid] = rsqrtf(_s * (1.0f / 1024.0f) + 1e-6f); } } while (0)
    Unit cur, nxt; int ui = 0;
    if (!S.next(0, cur)) return;
    PG8_RS_ISSUE(cur); PG8_RS_COMMIT(0);
    f32x4 acc[2][2][4][2];
#pragma unroll
    for (int a = 0; a < 2; ++a)
#pragma unroll
        for (int b = 0; b < 2; ++b)
#pragma unroll
            for (int m = 0; m < 4; ++m)
#pragma unroll
                for (int n = 0; n < 2; ++n) acc[a][b][m][n] = (f32x4){0.f, 0.f, 0.f, 0.f};
    bf16x8 At[4][2], B0[2][2], B1[2][2];
    const char* cA = (const char*)g.A + (size_t)cur.pm * tstep; const char* cB = (const char*)g.Bt + (size_t)cur.pn * tstep;
    S.a_ready(cur);
    if constexpr (SP2) {
        PG8_STAGE(PG8_SB(0, 0), cB, voffB); PG8_STAGE(PG8_SB(0, 1), cB + hstep, voffB); PG8_STAGE(PG8_SA(0, 0), cA, voffA); PG8_STAGE(PG8_SA(0, 1), cA + hstep, voffA);
        if (wr == 1) PG8_BAR;
        PG8_WAIT_V(2); PG8_BAR;
        PG8_STAGE(PG8_SB(1, 0), cB + kstep, voffB); PG8_STAGE(PG8_SA(1, 0), cA + kstep, voffA); PG8_STAGE(PG8_SB(1, 1), cB + hstep + kstep, voffB);
        PG8_WAIT_V(6); PG8_BAR;
    } else {
        PG8_STAGE(PG8_SB(0, 0), cB, voffB); PG8_STAGE(PG8_SA(0, 0), cA, voffA); PG8_STAGE(PG8_SB(0, 1), cB + hstep, voffB); PG8_STAGE(PG8_SA(0, 1), cA + hstep, voffA);
        if (wr == 1) PG8_BAR;
        PG8_WAIT_V(4); PG8_BAR;
        PG8_STAGE(PG8_SB(1, 0), cB + kstep, voffB); PG8_STAGE(PG8_SA(1, 0), cA + kstep, voffA); PG8_STAGE(PG8_SB(1, 1), cB + hstep + kstep, voffB);
        PG8_WAIT_V(6); PG8_BAR;
    }
    for (;;) {
        const bool has_next = S.next(ui + 1, nxt);
        const char* nA = has_next ? (const char*)g.A + (size_t)nxt.pm * tstep : cA; const char* nB = has_next ? (const char*)g.Bt + (size_t)nxt.pn * tstep : cB;
        for (int t = 0; t < nt; t += 2) {
            const bool last = (t == nt - 2);
            const char* a1 = cA + (size_t)(t + 1) * kstep;
            const char* a2 = last ? nA : cA + (size_t)(t + 2) * kstep; const char* b2 = last ? nB : cB + (size_t)(t + 2) * kstep;
            const char* a3 = a2 + kstep; const char* b3 = b2 + kstep;
            if (last && has_next) { S.a_ready(nxt); PG8_RS_ISSUE(nxt); }
            if constexpr (SP2) {
            PG8_LDB(B0, 0, 0); PG8_LDB(B1, 0, 1); PG8_SCHED; PG8_LDA(At, 0, 0); PG8_STAGE(PG8_SA(1, 1), a1 + hstep, voffA);
            PG8_WAIT_V(8); PG8_WAIT_L(0); PG8_BAR; PG8_MMA(0, 0, At, B0); PG8_MMA(0, 1, At, B1); PG8_BAR; PG8_SCHED;
            PG8_LDA(At, 0, 1); PG8_STAGE(PG8_SB(0, 0), b2, voffB); PG8_STAGE(PG8_SB(0, 1), b2 + hstep, voffB); PG8_STAGE(PG8_SA(0, 0), a2, voffA);
            PG8_WAIT_V(8); PG8_WAIT_L(0); PG8_BAR; PG8_MMA(1, 0, At, B0); PG8_MMA(1, 1, At, B1); PG8_BAR; PG8_SCHED;
            PG8_LDB(B0, 1, 0); PG8_LDB(B1, 1, 1); PG8_SCHED; PG8_LDA(At, 1, 0); PG8_STAGE(PG8_SA(0, 1), a2 + hstep, voffA);
            PG8_WAIT_V(8); PG8_WAIT_L(0); PG8_BAR; PG8_MMA(0, 0, At, B0); PG8_MMA(0, 1, At, B1); PG8_BAR; PG8_SCHED;
            PG8_LDA(At, 1, 1); PG8_STAGE(PG8_SB(1, 0), b3, voffB); PG8_STAGE(PG8_SB(1, 1), b3 + hstep, voffB); PG8_STAGE(PG8_SA(1, 0), a3, voffA);
            PG8_WAIT_V(8); PG8_WAIT_L(0); PG8_BAR; PG8_MMA(1, 0, At, B0); PG8_MMA(1, 1, At, B1); PG8_BAR; PG8_SCHED;
            if (last && has_next) PG8_RS_COMMIT((ui + 1) & 1);
            } else {
            PG8_LDB(B0, 0, 0); PG8_SCHED; PG8_LDA(At, 0, 0); PG8_STAGE(PG8_SA(1, 1), a1 + hstep, voffA);
            PG8_WAIT_L(8); PG8_BAR; PG8_WAIT_L(0); PG8_MMA(0, 0, At, B0); PG8_BAR; PG8_SCHED;
            PG8_LDB(B1, 0, 1); PG8_STAGE(PG8_SB(0, 0), b2, voffB);
            PG8_BAR; PG8_WAIT_L(0); PG8_MMA(0, 1, At, B1); PG8_BAR;
            PG8_LDA(At, 0, 1); PG8_STAGE(PG8_SA(0, 0), a2, voffA);
            PG8_BAR; PG8_WAIT_L(0); PG8_MMA(1, 0, At, B0); PG8_BAR; PG8_SCHED;
            PG8_STAGE(PG8_SB(0, 1), b2 + hstep, voffB);
            PG8_WAIT_V(6); PG8_BAR; PG8_MMA(1, 1, At, B1); PG8_BAR;
            PG8_LDB(B0, 1, 0); PG8_SCHED; PG8_LDA(At, 1, 0); PG8_STAGE(PG8_SA(0, 1), a2 + hstep, voffA);
            PG8_WAIT_L(8); PG8_BAR; PG8_WAIT_L(0); PG8_MMA(0, 0, At, B0); PG8_BAR; PG8_SCHED;
            PG8_LDB(B1, 1, 1); PG8_STAGE(PG8_SB(1, 0), b3, voffB);
            PG8_BAR; PG8_WAIT_L(0); PG8_MMA(0, 1, At, B1); PG8_BAR;
            PG8_LDA(At, 1, 1); PG8_STAGE(PG8_SA(1, 0), a3, voffA);
            PG8_BAR; PG8_WAIT_L(0); PG8_MMA(1, 0, At, B0); PG8_BAR; PG8_SCHED;
            PG8_STAGE(PG8_SB(1, 1), b3 + hstep, voffB);
            PG8_WAIT_V(6); PG8_BAR; PG8_MMA(1, 1, At, B1); PG8_BAR;
            }
        }
        if constexpr (ALIGN_EPI) { if (wr == 0) PG8_BAR; }
        E(acc, cur, wr, wc, fr, fq, rsl + (ui & 1) * 256);
        if (!has_next) break;
#pragma unroll
        for (int a = 0; a < 2; ++a)
#pragma unroll
            for (int b = 0; b < 2; ++b)
#pragma unroll
                for (int m = 0; m < 4; ++m)
#pragma unroll
                    for (int n = 0; n < 2; ++n) acc[a][b][m][n] = (f32x4){0.f, 0.f, 0.f, 0.f};
        cur = nxt; cA = nA; cB = nB; ++ui;
        if constexpr (ALIGN_EPI) { if (wr == 1) PG8_BAR; }
    }
    PG8_WAIT_V(0);
    if constexpr (!ALIGN_EPI) { if (wr == 0) PG8_BAR; }
    PG8_BAR;
#undef PG8_RS_ISSUE
#undef PG8_RS_COMMIT
#undef PG8_SA
#undef PG8_SB
#undef PG8_STAGE
#undef PG8_LDA
#undef PG8_LDB
#undef PG8_MMA
#undef PG8_WAIT_V
#undef PG8_WAIT_L
#undef PG8_BAR
#undef PG8_SCHED
}

__device__ __forceinline__ void load_rstd8(const float* SS, int row0, int fq, float (&rs)[2][4]) {
    f32x4 t[2][4];
#pragma unroll
    for (int ai = 0; ai < 2; ++ai)
#pragma unroll
        for (int m = 0; m < 4; ++m) t[ai][m] = *(const f32x4*)(SS + (size_t)(row0 + ai * HALF + m * 16) * 16 + 4 * fq);
    asm volatile("" ::: "memory");
#pragma unroll
    for (int ai = 0; ai < 2; ++ai)
#pragma unroll
        for (int m = 0; m < 4; ++m) { float sm = (t[ai][m].x + t[ai][m].y) + (t[ai][m].z + t[ai][m].w); sm += __shfl_xor(sm, 16); sm += __shfl_xor(sm, 32);
            rs[ai][m] = rsqrtf(sm * (1.0f / 1024.0f) + EPS); }
}
struct EpiSwiGLU {
    static constexpr bool PERM = true, RS = true;
    bf16_t* O; const float* SS;
    __device__ __forceinline__ void operator()(const f32x4 (&acc)[2][2][4][2], const Unit& u, int wr, int wc, int fr, int fq, const PG8_LAS float* rsl) const {
        const int row0 = u.pm * BM + wr * 64 + fr; const int col0 = u.pn * 128 + wc * 32 + 8 * fq;
        float rsv[2][4];
#pragma unroll
        for (int ai = 0; ai < 2; ++ai)
#pragma unroll
            for (int m = 0; m < 4; ++m) rsv[ai][m] = rsl[ai * HALF + wr * 64 + m * 16 + fr];
#pragma unroll
        for (int ai = 0; ai < 2; ++ai)
#pragma unroll
            for (int m = 0; m < 4; ++m) {
                const int row = row0 + ai * HALF + m * 16; const float rs = rsv[ai][m], k1 = -LOG2E * rs, rs2 = rs * rs;
                const f32x4 g0 = acc[ai][0][m][0], g1 = acc[ai][0][m][1], u0 = acc[ai][1][m][0], u1 = acc[ai][1][m][1];
                const f32x2 o0 = swiglu2((f32x2){g0[0], g0[1]}, (f32x2){u0[0], u0[1]}, k1, rs2), o1 = swiglu2((f32x2){g0[2], g0[3]}, (f32x2){u0[2], u0[3]}, k1, rs2);
                const f32x2 o2 = swiglu2((f32x2){g1[0], g1[1]}, (f32x2){u1[0], u1[1]}, k1, rs2), o3 = swiglu2((f32x2){g1[2], g1[3]}, (f32x2){u1[2], u1[3]}, k1, rs2);
                u32x4 w;
                w.x = pk_bf16(o0.x, o0.y); w.y = pk_bf16(o1.x, o1.y); w.z = pk_bf16(o2.x, o2.y); w.w = pk_bf16(o3.x, o3.y);
                *(u32x4*)(O + (size_t)row * DFF + col0) = w;
            }
    }
};
struct EpiResidual {
    static constexpr bool PERM = true, RS = false;
    const float* baseP; const float* baseS; bf16_t* XB; float* SS; float alpha; int f32base;
    __device__ __forceinline__ void operator()(const f32x4 (&acc)[2][2][4][2], const Unit& u, int wr, int wc, int fr, int fq, const PG8_LAS float* rsl) const {
        const int row0 = u.pm * BM + wr * 64 + fr; const int colb = u.pn * BM + wc * 32 + 8 * fq;
        const bool samp = u.pm >= 256;
        if (f32base) {
#pragma unroll
            for (int ai = 0; ai < 2; ++ai)
#pragma unroll
                for (int mh = 0; mh < 2; ++mh) {
                    f32x4 fb[2][2][2];
#pragma unroll
                    for (int m2 = 0; m2 < 2; ++m2) { const int row = row0 + ai * HALF + (2 * mh + m2) * 16;
                        const float* bp = (samp ? baseS + (size_t)(row - MP) * DM : baseP + (size_t)row * DM) + colb;
#pragma unroll
                        for (int bj = 0; bj < 2; ++bj) { fb[m2][bj][0] = *(const f32x4*)(bp + bj * HALF); fb[m2][bj][1] = *(const f32x4*)(bp + bj * HALF + 4); } }
                    asm volatile("" : "+v"(fb[0][0][0]), "+v"(fb[0][0][1]), "+v"(fb[0][1][0]), "+v"(fb[0][1][1]), "+v"(fb[1][0][0]), "+v"(fb[1][0][1]), "+v"(fb[1][1][0]), "+v"(fb[1][1][1]) :: "memory");
#pragma unroll
                    for (int m2 = 0; m2 < 2; ++m2) { const int m = 2 * mh + m2; const int row = row0 + ai * HALF + m * 16; float ss = 0.f;
#pragma unroll
                        for (int bj = 0; bj < 2; ++bj) {
                            const f32x4 x0 = fb[m2][bj][0] + acc[ai][bj][m][0] * alpha, x1 = fb[m2][bj][1] + acc[ai][bj][m][1] * alpha;
                            u32x4 w; w.x = pk_bf16(x0[0], x0[1]); w.y = pk_bf16(x0[2], x0[3]); w.z = pk_bf16(x1[0], x1[1]); w.w = pk_bf16(x1[2], x1[3]);
                            *(u32x4*)(XB + (size_t)row * DM + colb + bj * HALF) = w;
                            ss += (x0[0] * x0[0] + x0[1] * x0[1]) + (x0[2] * x0[2] + x0[3] * x0[3]) + (x1[0] * x1[0] + x1[1] * x1[1]) + (x1[2] * x1[2] + x1[3] * x1[3]);
                        }
                        ss += __shfl_xor(ss, 16); ss += __shfl_xor(ss, 32);
                        if (fq == 0) SS[(size_t)row * 16 + u.pn * 4 + wc] = ss; }
                }
            return;
        }
#pragma unroll
        for (int ai = 0; ai < 2; ++ai) {
            u32x4 wv[4][2];
#pragma unroll
            for (int m = 0; m < 4; ++m)
#pragma unroll
                for (int bj = 0; bj < 2; ++bj) wv[m][bj] = *(const u32x4*)(XB + (size_t)(row0 + ai * HALF + m * 16) * DM + colb + bj * HALF);
            asm volatile("" : "+v"(wv[0][0]), "+v"(wv[0][1]), "+v"(wv[1][0]), "+v"(wv[1][1]), "+v"(wv[2][0]), "+v"(wv[2][1]), "+v"(wv[3][0]), "+v"(wv[3][1]) :: "memory");
#pragma unroll
            for (int m = 0; m < 4; ++m) {
                const int row = row0 + ai * HALF + m * 16;
                float ss = 0.f;
#pragma unroll
                for (int bj = 0; bj < 2; ++bj) {
                    const u32x4 wq = wv[m][bj];
                    const f32x4 b0 = (f32x4){bf_lo(wq.x), bf_hi(wq.x), bf_lo(wq.y), bf_hi(wq.y)}, b1 = (f32x4){bf_lo(wq.z), bf_hi(wq.z), bf_lo(wq.w), bf_hi(wq.w)};
                    const f32x4 x0 = b0 + acc[ai][bj][m][0] * alpha, x1 = b1 + acc[ai][bj][m][1] * alpha;
                    u32x4 w; w.x = pk_bf16(x0[0], x0[1]); w.y = pk_bf16(x0[2], x0[3]); w.z = pk_bf16(x1[0], x1[1]); w.w = pk_bf16(x1[2], x1[3]);
                    *(u32x4*)(XB + (size_t)row * DM + colb + bj * HALF) = w;
                    ss += (x0[0] * x0[0] + x0[1] * x0[1]) + (x0[2] * x0[2] + x0[3] * x0[3]) + (x1[0] * x1[0] + x1[1] * x1[1]) + (x1[2] * x1[2] + x1[3] * x1[3]);
                }
                ss += __shfl_xor(ss, 16); ss += __shfl_xor(ss, 32);
                if (fq == 0) SS[(size_t)row * 16 + u.pn * 4 + wc] = ss;
            }
        }
    }
};
struct EpiProjEven {
    static constexpr bool PERM = true, RS = true;
    bf16_t* QKVU; const float* SS; float* out;
    __device__ __forceinline__ void operator()(const f32x4 (&acc)[2][2][4][2], const Unit& u, int wr, int wc, int fr, int fq, const PG8_LAS float* rsl) const {
        const int sec = u.pn >> 1; const bool samp = u.pm >= 256;
        const int row0 = u.pm * BM + wr * 64 + fr; const int colb = u.pn * BM + wc * 32 + 8 * fq;
        float* o32 = nullptr;
        if (sec == 1) o32 = out + (samp ? OFF_KS : OFF_KP); else if (sec == 2) o32 = out + (samp ? OFF_VS : OFF_VP);
        float* opool = out + (samp ? OFF_PS : OFF_PP);
        const float qs = (sec == 0) ? QSCALE : 1.0f;
        float rsv[2][4];
#pragma unroll
        for (int ai = 0; ai < 2; ++ai)
#pragma unroll
            for (int m = 0; m < 4; ++m) rsv[ai][m] = rsl[ai * HALF + wr * 64 + m * 16 + fr];
#pragma unroll
        for (int ai = 0; ai < 2; ++ai)
#pragma unroll
            for (int m = 0; m < 4; ++m) {
                const int row = row0 + ai * HALF + m * 16; const float rs = rsv[ai][m] * qs;
                const int orow = samp ? row - MP : row;
                bool poolrow = false; int prow = 0;
                if (sec == 3) {
                    if (!samp) { const int t = row & 2047; poolrow = t >= 2033; prow = (row >> 11) * 15 + t - 2033; }
                    else { const int rr = row - MP, t = rr & 31; poolrow = t >= 17; prow = (rr >> 5) * 15 + t - 17; }
                }
#pragma unroll
                for (int bj = 0; bj < 2; ++bj) {
                    const int col = colb + bj * HALF;
                    const f32x4 v0 = acc[ai][bj][m][0] * rs, v1 = acc[ai][bj][m][1] * rs;
                    u32x4 w; w.x = pk_bf16(v0[0], v0[1]); w.y = pk_bf16(v0[2], v0[3]); w.z = pk_bf16(v1[0], v1[1]); w.w = pk_bf16(v1[2], v1[3]);
                    *(u32x4*)(QKVU + (size_t)row * 2048 + col) = w;
                    if (o32) { float* p = o32 + (size_t)orow * 512 + (col & 511); __builtin_nontemporal_store(v0, (f32x4*)p); __builtin_nontemporal_store(v1, (f32x4*)(p + 4)); }
                    if (poolrow) { float* p = opool + (size_t)prow * 512 + (col & 511); *(f32x4*)p = v0; *(f32x4*)(p + 4) = v1; }
                }
            }
    }
};
struct EpiSguProj {
    static constexpr bool PERM = true, RS = true;
    bf16_t* ZUV; const float* SS; float* SS2;
    __device__ __forceinline__ void operator()(const f32x4 (&acc)[2][2][4][2], const Unit& u, int wr, int wc, int fr, int fq, const PG8_LAS float* rsl) const {
        const int row0 = u.pm * BM + wr * 64 + fr; const int colb = u.pn * BM + wc * 32 + 8 * fq;
        const bool isv = u.pn >= 4;
        float rsv[2][4];
#pragma unroll
        for (int ai = 0; ai < 2; ++ai)
#pragma unroll
            for (int m = 0; m < 4; ++m) rsv[ai][m] = rsl[ai * HALF + wr * 64 + m * 16 + fr];
#pragma unroll
        for (int ai = 0; ai < 2; ++ai)
#pragma unroll
            for (int m = 0; m < 4; ++m) {
                const int row = row0 + ai * HALF + m * 16; const float rs = rsv[ai][m];
                float ss = 0.f;
#pragma unroll
                for (int bj = 0; bj < 2; ++bj) {
                    const int col = colb + bj * HALF;
                    f32x4 v0 = acc[ai][bj][m][0] * rs, v1 = acc[ai][bj][m][1] * rs;
                    { const f32x2 a0 = gelu2((f32x2){v0[0], v0[1]}), a1 = gelu2((f32x2){v0[2], v0[3]}), a2 = gelu2((f32x2){v1[0], v1[1]}), a3 = gelu2((f32x2){v1[2], v1[3]});
                      v0 = (f32x4){a0.x, a0.y, a1.x, a1.y}; v1 = (f32x4){a2.x, a2.y, a3.x, a3.y}; }
                    u32x4 w; w.x = pk_bf16(v0[0], v0[1]); w.y = pk_bf16(v0[2], v0[3]); w.z = pk_bf16(v1[0], v1[1]); w.w = pk_bf16(v1[2], v1[3]);
                    *(u32x4*)(ZUV + (size_t)row * 2048 + col) = w;
                    ss += (v0[0] * v0[0] + v0[1] * v0[1]) + (v0[2] * v0[2] + v0[3] * v0[3]) + (v1[0] * v1[0] + v1[1] * v1[1]) + (v1[2] * v1[2] + v1[3] * v1[3]);
                }
                if (isv) { ss += __shfl_xor(ss, 16); ss += __shfl_xor(ss, 32); if (fq == 0) SS2[(size_t)row * 16 + (u.pn - 4) * 4 + wc] = ss; }
            }
    }
};
}

__device__ __forceinline__ void p0_tr_item(const float* W, int ldw, int k0, int src_col0, bf16_t* WT, int K, int dst_row0, const float* gk, const float* sn, LAS float* scr, int lane) {
    const int c = lane & 7;
    f32x4 wq[8]; f32x4 ga = (f32x4){1.f, 1.f, 1.f, 1.f}, gb = ga;
    const float* wp = W + (size_t)(k0 + (lane >> 5)) * ldw + src_col0 + (lane & 31);
#pragma unroll
    for (int i = 0; i < 32; ++i) wq[i >> 2][i & 3] = wp[(size_t)(2 * i) * ldw];
    if (gk) { ga = *(const f32x4*)(gk + k0 + 8 * c); gb = *(const f32x4*)(gk + k0 + 8 * c + 4); }
    asm volatile("" : "+v"(wq[0]), "+v"(wq[1]), "+v"(wq[2]), "+v"(wq[3]), "+v"(wq[4]), "+v"(wq[5]), "+v"(wq[6]), "+v"(wq[7]), "+v"(ga), "+v"(gb) :: "memory");
#pragma unroll
    for (int i = 0; i < 32; ++i) scr[(2 * i + (lane >> 5)) * 33 + (lane & 31)] = wq[i >> 2][i & 3];
    asm volatile("s_waitcnt lgkmcnt(0)" ::: "memory");
#pragma unroll
    for (int j = 0; j < 4; ++j) { const int n = (lane >> 3) + 8 * j; const LAS float* sp = scr + (8 * c) * 33 + n; const float sc = sn ? sn[n] : 1.0f;
        u32x4 o; o.x = pk_bf16(sp[0 * 33] * ga.x * sc, sp[1 * 33] * ga.y * sc); o.y = pk_bf16(sp[2 * 33] * ga.z * sc, sp[3 * 33] * ga.w * sc);
        o.z = pk_bf16(sp[4 * 33] * gb.x * sc, sp[5 * 33] * gb.y * sc); o.w = pk_bf16(sp[6 * 33] * gb.z * sc, sp[7 * 33] * gb.w * sc);
        *(u32x4*)(WT + (size_t)(dst_row0 + n) * K + k0 + 8 * c) = o; }
    asm volatile("s_waitcnt lgkmcnt(0)" ::: "memory");
}

__device__ __forceinline__ void p0_weight_items(const Args& a, LAS unsigned char* lds, int mode_lo, int mode_hi, int worker, int nworkers) {
    const int tid = fresh_tid(), lane = tid & 63, wid = __builtin_amdgcn_readfirstlane(tid >> 6);
    unsigned char* ws = a.ws;
    LAS float* scr = (LAS float*)(lds + wid * 8704);
    const float* norm_g = a.in[6];
    for (int mode = mode_lo; mode < mode_hi; ++mode)
    for (int ix = worker; ix < (mode == 0 ? 5792 : 14208); ix += nworkers) {
        const float* W; int ldw, k0, sc0, K, dr0; bf16_t* WT; const float* gk = nullptr; const float* sn = nullptr;
        int r;
        if (mode == 0) r = ix < 2816 ? ix : (ix < 4224 ? 11264 + (ix - 2816) : (ix < 5760 ? 16896 + (ix - 4224) : 19968 + (ix - 5760)));
        else r = ix < 8448 ? 2816 + ix : (ix < 12672 ? 12672 + (ix - 8448) : 18432 + (ix - 12672));
        if (r < 11264) { const int mi = r / 2816; r -= mi * 2816; const int kb = r / 176, nb = r % 176, n0 = nb * 32, pn = n0 >> 8, bj = (n0 >> 7) & 1, jj = n0 & 127;
            W = a.in[7] + (size_t)mi * DM * NFF; ldw = NFF; k0 = kb * 64; sc0 = bj * DFF + pn * 128 + jj; WT = (bf16_t*)(ws + WS_W1) + (size_t)mi * NFF * DM; K = DM; dr0 = n0;
            gk = norm_g + ((mi >> 1) * 3 + ((mi & 1) ? 2 : 0)) * DM; }
        else if ((r -= 11264) < 5632) { const int mi = r / 1408; r -= mi * 1408; const int kb = r / 32, nb = r % 32;
            W = a.in[8] + (size_t)mi * DFF * DM; ldw = DM; k0 = kb * 64; sc0 = nb * 32; WT = (bf16_t*)(ws + WS_W2) + (size_t)mi * DM * DFF; K = DFF; dr0 = nb * 32; }
        else if ((r -= 5632) < 1024) { const int kb = r / 64, nb = r % 64, n0 = nb * 32;
            W = a.in[9]; ldw = 2056; k0 = kb * 64; sc0 = n0 < 1536 ? n0 : n0 + 8; WT = (bf16_t*)(ws + WS_WEIN); K = DM; dr0 = n0; gk = norm_g + 1 * DM; }
        else if ((r -= 1024) < 512) { const int kb = r / 32, nb = r % 32;
            W = a.in[13]; ldw = DM; k0 = kb * 64; sc0 = nb * 32; WT = (bf16_t*)(ws + WS_WEOUT); K = DM; dr0 = nb * 32; }
        else if ((r -= 512) < 1024) { const int kb = r / 64, nb = r % 64;
            W = a.in[14]; ldw = 2048; k0 = kb * 64; sc0 = nb * 32; WT = (bf16_t*)(ws + WS_WSIN); K = DM; dr0 = nb * 32; gk = norm_g + 4 * DM; }
        else if ((r -= 1024) < 512) { const int kb = r / 32, nb = r % 32;
            W = a.in[18]; ldw = DM; k0 = kb * 64; sc0 = nb * 32; WT = (bf16_t*)(ws + WS_WSOUT); K = DM; dr0 = nb * 32; }
        else { r -= 512; const int g = r >> 3, kb = (r >> 2) & 1, nb = r & 3;
            W = a.in[11] + (size_t)g * 128 * 128; ldw = 128; k0 = kb * 64; sc0 = nb * 32; WT = (bf16_t*)(ws + WS_POOLWT) + (size_t)g * 128 * 128; K = 128; dr0 = nb * 32; sn = a.in[12] + g * 128 + nb * 32; }
        p0_tr_item(W, ldw, k0, sc0, WT, K, dr0, gk, sn, scr, lane);
    }
}

__device__ __forceinline__ void p0_phase(const Args& a, LAS unsigned char* lds) {
    const int tid = fresh_tid(), lane = tid & 63, wid = __builtin_amdgcn_readfirstlane(tid >> 6);
    const int gw = blockIdx.x * 8 + wid, NGW = gridDim.x * 8;
    unsigned char* ws = a.ws;
    const float* norm_g = a.in[6];
    p0_weight_items(a, lds, 0, gridDim.x == 256 ? 1 : 2, gw, NGW);
    const int gt = blockIdx.x * 512 + tid, NGT = gridDim.x * 512;
    { bf16_t* WF = (bf16_t*)(ws + WS_WF); const float* W = a.in[9];
      for (int idx = gt; idx < 16 * DM; idx += NGT) { const int rr = idx >> 10, k = idx & 1023; const float v = rr < 8 ? W[(size_t)k * 2056 + 1536 + rr] * norm_g[DM + k] : 0.f; WF[idx] = (bf16_t)(pk_bf16(v, 0.f) & 0xffffu); } }
    { bf16_t* SW = (bf16_t*)(ws + WS_SGUW); const float* W = a.in[16];
      for (int idx = gt; idx < 8 * 128 * 128; idx += NGT) { const int t = (idx >> 7) & 127, s = idx & 127; const float v = ((s >> 6) <= (t >> 6)) ? W[idx] : 0.f; SW[idx] = (bf16_t)(pk_bf16(v, 0.f) & 0xffffu); } }
    bf16_t* XB = (bf16_t*)(ws + WS_XB); float* SS = (float*)(ws + WS_SS);
    for (int row0 = gw; row0 < MT; row0 += 4 * NGW) {
        f32x4 v[4][4];
#pragma unroll
        for (int i = 0; i < 4; ++i) { const int row = min(row0 + i * NGW, MT - 1); const float* xr = row < MP ? a.in[0] + (size_t)row * DM : a.in[1] + (size_t)(row - MP) * DM;
#pragma unroll
            for (int j = 0; j < 4; ++j) v[i][j] = __builtin_nontemporal_load((const f32x4*)(xr + (lane + 64 * j) * 4)); }
        asm volatile("" : "+v"(v[0][0]), "+v"(v[0][1]), "+v"(v[0][2]), "+v"(v[0][3]), "+v"(v[1][0]), "+v"(v[1][1]), "+v"(v[1][2]), "+v"(v[1][3]),
                     "+v"(v[2][0]), "+v"(v[2][1]), "+v"(v[2][2]), "+v"(v[2][3]), "+v"(v[3][0]), "+v"(v[3][1]), "+v"(v[3][2]), "+v"(v[3][3]) :: "memory");
#pragma unroll
        for (int i = 0; i < 4; ++i) { const int row = row0 + i * NGW; if (row < MT) { float sq = 0.f;
#pragma unroll
            for (int j = 0; j < 4; ++j) { sq += (v[i][j].x * v[i][j].x + v[i][j].y * v[i][j].y) + (v[i][j].z * v[i][j].z + v[i][j].w * v[i][j].w);
                u32x2 w; w.x = pk_bf16(v[i][j].x, v[i][j].y); w.y = pk_bf16(v[i][j].z, v[i][j].w); *(u32x2*)(XB + (size_t)row * DM + (lane + 64 * j) * 4) = w; }
            sq = wave_sum(sq);
            if (lane < 16) SS[(size_t)row * 16 + lane] = lane == 0 ? sq : 0.f; } }
    }
}

__device__ __forceinline__ void f_unit(int tile, const bf16_t* XB, const bf16_t* WF, const float* SS, const float* bf, float* out) {
    const int tid = fresh_tid(), lane = tid & 63, wid = __builtin_amdgcn_readfirstlane(tid >> 6), fr = lane & 15, fq = lane >> 4;
#pragma unroll 1
    for (int mf = 0; mf < 2; ++mf) {
        const int rowb = tile * 256 + wid * 32 + mf * 16;
        const bf16_t* ap = XB + (size_t)(rowb + fr) * DM + fq * 8; const bf16_t* bp = WF + (size_t)fr * DM + fq * 8;
        f32x4 acc = (f32x4){0.f, 0.f, 0.f, 0.f};
#pragma unroll 1
        for (int kb = 0; kb < 4; ++kb) {
            bf16x8 av[8], bv[8];
#pragma unroll
            for (int uu = 0; uu < 8; ++uu) { av[uu] = *(const bf16x8*)(ap + (kb * 8 + uu) * 32); bv[uu] = *(const bf16x8*)(bp + (kb * 8 + uu) * 32); }
            asm volatile("" : "+v"(av[0]), "+v"(av[1]), "+v"(av[2]), "+v"(av[3]), "+v"(av[4]), "+v"(av[5]), "+v"(av[6]), "+v"(av[7]),
                         "+v"(bv[0]), "+v"(bv[1]), "+v"(bv[2]), "+v"(bv[3]), "+v"(bv[4]), "+v"(bv[5]), "+v"(bv[6]), "+v"(bv[7]) :: "memory");
#pragma unroll
            for (int uu = 0; uu < 8; ++uu) acc = __builtin_amdgcn_mfma_f32_16x16x32_bf16(bv[uu], av[uu], acc, 0, 0, 0);
        }
        const int row = rowb + fr;
        if (fq < 2) {
            const float rs = row_rstd(SS, row); f32x4 o;
#pragma unroll
            for (int e = 0; e < 4; ++e) { const float z = acc[e] * rs + bf[4 * fq + e]; o[e] = fminf(z, 0.f) - log1pf(__expf(-fabsf(z))); }
            float* p = row < MP ? out + OFF_FP + (size_t)row * 8 + 4 * fq : out + OFF_FS + (size_t)(row - MP) * 8 + 4 * fq;
            *(f32x4*)p = o;
        }
    }
}

constexpr int AT_C2 = 0, AT_K = 8448, AT_KB = 64 * 144, AT_VT = AT_K + 2 * AT_KB, AT_VB = 64 * 136, AT_WT = AT_VT + 2 * AT_VB;
__device__ __forceinline__ int crow(int r, int hi) { return (r & 3) + 8 * (r >> 2) + 4 * hi; }

__device__ __forceinline__ void scan2048(float v0, float v1, float v2, float v3, LAS unsigned char* lds) {
    const int tid = fresh_tid(), lane = tid & 63, wid = tid >> 6;
    LAS float* c2s = (LAS float*)(lds + AT_C2); LAS float* wt = (LAS float*)(lds + AT_WT);
    const float a0 = v0, a1 = a0 + v1, a2 = a1 + v2, a3 = a2 + v3;
    float x = a3;
#pragma unroll
    for (int off = 1; off < 64; off <<= 1) { const float y = __shfl_up(x, off); if (lane >= off) x += y; }
    if (lane == 63) wt[wid] = x;
    __syncthreads();
    float pre = x - a3;
    for (int w = 0; w < wid; ++w) pre += wt[w];
    c2s[4 * tid + 0] = (pre + a0) * LOG2E; c2s[4 * tid + 1] = (pre + a1) * LOG2E; c2s[4 * tid + 2] = (pre + a2) * LOG2E; c2s[4 * tid + 3] = (pre + a3) * LOG2E;
    __syncthreads();
}

struct AttnJob {
    const bf16_t* Qrow0;
    bf16_t* Orow0;
    int nqw, qpos0, NT, mode;
    const bf16_t* Kb;
    const float* cK; const float* cV;
};

__device__ __forceinline__ void attn_load(const AttnJob& J, int t, u32x4& kreg, u32x4& vreg) {
    const int tid = fresh_tid(), key = tid >> 3, ch = tid & 7, kidx = 64 * t + key;
    if (J.mode == 0) { const bf16_t* p = J.Kb + (size_t)kidx * 2048 + ch * 8; kreg = *(const u32x4*)p; vreg = *(const u32x4*)(p + 512); }
    else if (kidx < PAST) { const float* pk = J.cK + (size_t)kidx * 512 + ch * 8; const float* pv = J.cV + (size_t)kidx * 512 + ch * 8;
        const f32x4 a = *(const f32x4*)pk, b = *(const f32x4*)(pk + 4), c = *(const f32x4*)pv, d = *(const f32x4*)(pv + 4);
        kreg = (u32x4){pk_bf16(a.x, a.y), pk_bf16(a.z, a.w), pk_bf16(b.x, b.y), pk_bf16(b.z, b.w)};
        vreg = (u32x4){pk_bf16(c.x, c.y), pk_bf16(c.z, c.w), pk_bf16(d.x, d.y), pk_bf16(d.z, d.w)}; }
    else if (kidx < PAST + TS) { const bf16_t* p = J.Kb + (size_t)(kidx - PAST) * 2048 + ch * 8; kreg = *(const u32x4*)p; vreg = *(const u32x4*)(p + 512); }
    else { kreg = (u32x4){0u, 0u, 0u, 0u}; vreg = kreg; }
}
__device__ __forceinline__ void attn_stage(LAS unsigned char* lds, int buf, const u32x4& kreg, const u32x4& vreg) {
    const int tid = fresh_tid(), key = tid >> 3, ch = tid & 7;
    *(LAS u32x4*)(lds + AT_K + buf * AT_KB + key * 144 + ch * 16) = kreg;
    LAS bf16_t* vt = (LAS bf16_t*)(lds + AT_VT + buf * AT_VB) + (ch * 8) * 68 + key;
    vt[0 * 68] = (bf16_t)(vreg.x & 0xffffu); vt[1 * 68] = (bf16_t)(vreg.x >> 16);
    vt[2 * 68] = (bf16_t)(vreg.y & 0xffffu); vt[3 * 68] = (bf16_t)(vreg.y >> 16);
    vt[4 * 68] = (bf16_t)(vreg.z & 0xffffu); vt[5 * 68] = (bf16_t)(vreg.z >> 16);
    vt[6 * 68] = (bf16_t)(vreg.w & 0xffffu); vt[7 * 68] = (bf16_t)(vreg.w >> 16);
}

__device__ __forceinline__ void attn_tile(int t, int buf, LAS unsigned char* lds, const bf16x8 (&qr)[4], float cq2, int qlo, int qpos, int q32, int hi,
                                          float& mrun, float& lrun, f32x16& o0, f32x16& o1) {
    const LAS float* c2s = (const LAS float*)(lds + AT_C2);
    const LAS unsigned char* Kt = lds + AT_K + buf * AT_KB; const LAS unsigned char* Vt = lds + AT_VT + buf * AT_VB;
    f32x16 s0, s1;
#pragma unroll
    for (int j = 0; j < 4; ++j) {
        const f32x4 c0 = *(const LAS f32x4*)(c2s + 64 * t + 8 * j + 4 * hi), c1 = *(const LAS f32x4*)(c2s + 64 * t + 32 + 8 * j + 4 * hi);
#pragma unroll
        for (int e = 0; e < 4; ++e) { s0[4 * j + e] = cq2 - c0[e]; s1[4 * j + e] = cq2 - c1[e]; }
    }
#pragma unroll
    for (int d0 = 0; d0 < 4; ++d0) {
        const bf16x8 k0 = *(const LAS bf16x8*)(Kt + q32 * 144 + d0 * 32 + hi * 16);
        const bf16x8 k1 = *(const LAS bf16x8*)(Kt + (32 + q32) * 144 + d0 * 32 + hi * 16);
        s0 = __builtin_amdgcn_mfma_f32_32x32x16_bf16(k0, qr[d0], s0, 0, 0, 0);
        s1 = __builtin_amdgcn_mfma_f32_32x32x16_bf16(k1, qr[d0], s1, 0, 0, 0);
    }
    if (64 * t + 63 > qlo) {
#pragma unroll
        for (int r = 0; r < 16; ++r) { const int kv = 64 * t + crow(r, hi); if (kv > qpos) s0[r] = -INFINITY; if (kv + 32 > qpos) s1[r] = -INFINITY; }
    }
    float mx = fmaxf(s0[0], s1[0]);
#pragma unroll
    for (int r = 1; r < 16; ++r) mx = fmaxf(mx, fmaxf(s0[r], s1[r]));
    mx = fmaxf(mx, __shfl_xor(mx, 32));
    const float mnew = fmaxf(mrun, mx);
    if (__any(mnew > mrun)) {
        const float alpha = fexp2(mrun - mnew); lrun *= alpha;
#pragma unroll
        for (int r = 0; r < 16; ++r) { o0[r] *= alpha; o1[r] *= alpha; }
    }
    mrun = mnew;
    float ls = 0.f;
#pragma unroll
    for (int r = 0; r < 16; ++r) { s0[r] = fexp2(s0[r] - mnew); s1[r] = fexp2(s1[r] - mnew); ls += s0[r] + s1[r]; }
    lrun += ls;
#pragma unroll
    for (int p = 0; p < 2; ++p)
#pragma unroll
        for (int sx = 0; sx < 2; ++sx) {
            u32x4 pw;
            if (p == 0) pw = (u32x4){pk_bf16(s0[8 * sx + 0], s0[8 * sx + 1]), pk_bf16(s0[8 * sx + 2], s0[8 * sx + 3]), pk_bf16(s0[8 * sx + 4], s0[8 * sx + 5]), pk_bf16(s0[8 * sx + 6], s0[8 * sx + 7])};
            else        pw = (u32x4){pk_bf16(s1[8 * sx + 0], s1[8 * sx + 1]), pk_bf16(s1[8 * sx + 2], s1[8 * sx + 3]), pk_bf16(s1[8 * sx + 4], s1[8 * sx + 5]), pk_bf16(s1[8 * sx + 6], s1[8 * sx + 7])};
            const bf16x8 pf = __builtin_bit_cast(bf16x8, pw);
            const int ko = (32 * p + 16 * sx + 4 * hi) * 2;
            const u32x2 a0 = *(const LAS u32x2*)(Vt + q32 * 136 + ko), a1 = *(const LAS u32x2*)(Vt + q32 * 136 + ko + 16);
            const u32x2 b0 = *(const LAS u32x2*)(Vt + (32 + q32) * 136 + ko), b1 = *(const LAS u32x2*)(Vt + (32 + q32) * 136 + ko + 16);
            const bf16x8 vf0 = __builtin_bit_cast(bf16x8, (u32x4){a0.x, a0.y, a1.x, a1.y});
            const bf16x8 vf1 = __builtin_bit_cast(bf16x8, (u32x4){b0.x, b0.y, b1.x, b1.y});
            o0 = __builtin_amdgcn_mfma_f32_32x32x16_bf16(vf0, pf, o0, 0, 0, 0);
            o1 = __builtin_amdgcn_mfma_f32_32x32x16_bf16(vf1, pf, o1, 0, 0, 0);
        }
}

__device__ __forceinline__ void attn_unit(const AttnJob& J, LAS unsigned char* lds) {
    const int tid = fresh_tid(), lane = tid & 63, q32 = lane & 31, hi = lane >> 5; const int wid = __builtin_amdgcn_readfirstlane(tid >> 6);
    const LAS float* c2s = (const LAS float*)(lds + AT_C2);
    const bool active = wid < J.nqw;
    const int qlo = J.qpos0 + 32 * wid, qpos = qlo + q32;
    bf16x8 qr[4]; float cq2 = 0.f;
    if (active) {
#pragma unroll
        for (int d0 = 0; d0 < 4; ++d0) qr[d0] = *(const bf16x8*)(J.Qrow0 + (size_t)(32 * wid + q32) * 2048 + d0 * 16 + hi * 8);
        cq2 = c2s[qpos];
    } else {
#pragma unroll
        for (int d0 = 0; d0 < 4; ++d0) qr[d0] = (bf16x8){0, 0, 0, 0, 0, 0, 0, 0};
    }
    float mrun = -1e30f, lrun = 0.f; f32x16 o0, o1;
#pragma unroll
    for (int r = 0; r < 16; ++r) { o0[r] = 0.f; o1[r] = 0.f; }
    u32x4 kA, vA, kB, vB;
    attn_load(J, 0, kA, vA);
    if (J.NT > 1) attn_load(J, 1, kB, vB); else { kB = (u32x4){0u, 0u, 0u, 0u}; vB = kB; }
    for (int t = 0; t < J.NT; t += 2) {
        attn_stage(lds, 0, kA, vA);
        __syncthreads();
        if (t + 2 < J.NT) attn_load(J, t + 2, kA, vA);
        if (active && 64 * t <= qlo + 31) attn_tile(t, 0, lds, qr, cq2, qlo, qpos, q32, hi, mrun, lrun, o0, o1);
        if (t + 1 < J.NT) {
            attn_stage(lds, 1, kB, vB);
            __syncthreads();
            if (t + 3 < J.NT) attn_load(J, t + 3, kB, vB);
            if (active && 64 * (t + 1) <= qlo + 31) attn_tile(t + 1, 1, lds, qr, cq2, qlo, qpos, q32, hi, mrun, lrun, o0, o1);
        }
    }
    if (active) {
        const float lt = lrun + __shfl_xor(lrun, 32); const float inv = 1.0f / lt;
        bf16_t* op = J.Orow0 + (size_t)(32 * wid + q32) * DM;
#pragma unroll
        for (int j = 0; j < 4; ++j) {
            u32x2 w0, w1;
            w0.x = pk_bf16(o0[4 * j + 0] * inv, o0[4 * j + 1] * inv); w0.y = pk_bf16(o0[4 * j + 2] * inv, o0[4 * j + 3] * inv);
            w1.x = pk_bf16(o1[4 * j + 0] * inv, o1[4 * j + 1] * inv); w1.y = pk_bf16(o1[4 * j + 2] * inv, o1[4 * j + 3] * inv);
            *(u32x2*)(op + 8 * j + 4 * hi) = w0; *(u32x2*)(op + 32 + 8 * j + 4 * hi) = w1;
        }
    }
    __syncthreads();
}

__device__ __forceinline__ void pool_unit(int tile, int g, const bf16_t* QKVU, const float* state_pool, const bf16_t* POOLWT, bf16_t* MIX, LAS unsigned char* lds) {
    const int tid = fresh_tid(), lane = tid & 63, wid = __builtin_amdgcn_readfirstlane(tid >> 6), fr = lane & 15, fq = lane >> 4;
    LAS float* U = (LAS float*)lds; LAS bf16_t* Dm = (LAS bf16_t*)(lds + 96256);
    const bool samp = tile >= 512; const int r0 = tile * 128; const int t0 = r0 & 2047;
    bf16x8 wv[4][8];
#pragma unroll
    for (int ks = 0; ks < 4; ++ks)
#pragma unroll
        for (int nf = 0; nf < 8; ++nf) wv[ks][nf] = *(const bf16x8*)(POOLWT + (size_t)(g * 128 + 16 * nf + fr) * 128 + 32 * ks + 8 * fq);
    if (!samp) {
        u32x4 uw[5];
#pragma unroll
        for (int it = 0; it < 5; ++it) { const int idx = tid + 512 * it, row = idx >> 4, ch = idx & 15;
            const int grow = max(r0 - 15 + min(row, 142), 0);
            uw[it] = *(const u32x4*)(QKVU + (size_t)grow * 2048 + 1536 + g * 128 + ch * 8); }
        asm volatile("" : "+v"(uw[0]), "+v"(uw[1]), "+v"(uw[2]), "+v"(uw[3]), "+v"(uw[4]) :: "memory");
#pragma unroll
        for (int it = 0; it < 5; ++it) { const int idx = tid + 512 * it, row = idx >> 4, ch = idx & 15;
            if (idx < 143 * 16) { f32x4 lo = (f32x4){0.f, 0.f, 0.f, 0.f}, hi4 = lo; const u32x4 w = uw[it];
                if (t0 - 15 + row >= 0) { lo = (f32x4){bf_lo(w.x), bf_hi(w.x), bf_lo(w.y), bf_hi(w.y)}; hi4 = (f32x4){bf_lo(w.z), bf_hi(w.z), bf_lo(w.w), bf_hi(w.w)}; }
                *(LAS f32x4*)(U + row * 128 + ch * 8) = lo; *(LAS f32x4*)(U + row * 128 + ch * 8 + 4) = hi4; } }
    } else {
        for (int idx = tid; idx < 188 * 16; idx += 512) { const int row = idx >> 4, ch = idx & 15, sb = row / 47, rr = row - sb * 47, b = (tile - 512) * 4 + sb; f32x4 lo, hi4;
            if (rr < 15) { const float* p = state_pool + (size_t)(b * 15 + rr) * 512 + g * 128 + ch * 8; lo = *(const f32x4*)p; hi4 = *(const f32x4*)(p + 4); }
            else { const u32x4 w = *(const u32x4*)(QKVU + (size_t)(MP + b * 32 + rr - 15) * 2048 + 1536 + g * 128 + ch * 8);
                lo = (f32x4){bf_lo(w.x), bf_hi(w.x), bf_lo(w.y), bf_hi(w.y)}; hi4 = (f32x4){bf_lo(w.z), bf_hi(w.z), bf_lo(w.w), bf_hi(w.w)}; }
            *(LAS f32x4*)(U + row * 128 + ch * 8) = lo; *(LAS f32x4*)(U + row * 128 + ch * 8 + 4) = hi4; }
    }
    __syncthreads();
    {
        const int c = tid & 127, rq = tid >> 7, w = 2 << g;
        const int ubase = samp ? rq * 47 : 0, tl0 = samp ? 0 : 32 * rq, pos0 = samp ? PAST : (t0 + 32 * rq);
        const LAS float* Uc = U + (ubase + 15 + tl0) * 128 + c;
        const float invw = 1.0f / (float)w;
        float wsum = 0.f;
        for (int j = 1; j < w; ++j) wsum += Uc[-j * 128];
        for (int i = 0; i < 32; ++i) {
            const float cur = Uc[i * 128]; wsum += cur;
            const int np = pos0 + i + 1;
            const float d = wsum * (np >= w ? invw : frcp((float)np)) - cur;
            Dm[(32 * rq + i) * 136 + c] = (bf16_t)(pk_bf16(d, 0.f) & 0xffffu);
            wsum -= Uc[(i - (w - 1)) * 128];
        }
    }
    __syncthreads();
    {
        f32x4 acc[8];
#pragma unroll
        for (int nf = 0; nf < 8; ++nf) acc[nf] = (f32x4){0.f, 0.f, 0.f, 0.f};
        asm volatile("" : "+v"(wv[0][0]), "+v"(wv[0][1]), "+v"(wv[0][2]), "+v"(wv[0][3]), "+v"(wv[0][4]), "+v"(wv[0][5]), "+v"(wv[0][6]), "+v"(wv[0][7]),
                     "+v"(wv[1][0]), "+v"(wv[1][1]), "+v"(wv[1][2]), "+v"(wv[1][3]), "+v"(wv[1][4]), "+v"(wv[1][5]), "+v"(wv[1][6]), "+v"(wv[1][7]));
        asm volatile("" : "+v"(wv[2][0]), "+v"(wv[2][1]), "+v"(wv[2][2]), "+v"(wv[2][3]), "+v"(wv[2][4]), "+v"(wv[2][5]), "+v"(wv[2][6]), "+v"(wv[2][7]),
                     "+v"(wv[3][0]), "+v"(wv[3][1]), "+v"(wv[3][2]), "+v"(wv[3][3]), "+v"(wv[3][4]), "+v"(wv[3][5]), "+v"(wv[3][6]), "+v"(wv[3][7]));
#pragma unroll
        for (int ks = 0; ks < 4; ++ks) {
            const bf16x8 av = *(const LAS bf16x8*)(Dm + (16 * wid + fr) * 136 + 32 * ks + 8 * fq);
#pragma unroll
            for (int nf = 0; nf < 8; ++nf) acc[nf] = __builtin_amdgcn_mfma_f32_16x16x32_bf16(wv[ks][nf], av, acc[nf], 0, 0, 0);
        }
        const int row = r0 + 16 * wid + fr;
#pragma unroll
        for (int nf = 0; nf < 8; ++nf) { u32x2 w; w.x = pk_bf16(acc[nf][0], acc[nf][1]); w.y = pk_bf16(acc[nf][2], acc[nf][3]);
            *(u32x2*)(MIX + (size_t)row * DM + 512 + g * 128 + 16 * nf + 4 * fq) = w; }
    }
    __syncthreads();
}

__device__ __forceinline__ void sgu_unit(int chunk, int g, const bf16_t* ZUV, const float* SS2, const float* gn, const bf16_t* SGUW, const float* bs, bf16_t* MIX, LAS unsigned char* lds) {
    const int tid = fresh_tid(), lane = tid & 63, wid = __builtin_amdgcn_readfirstlane(tid >> 6), q32 = lane & 31, hi = lane >> 5;
    LAS bf16_t* ZT = (LAS bf16_t*)lds;
    const int r0 = chunk * 128;
    const int tb = wid & 3, cb0 = (wid >> 2) * 2, t = 32 * tb + q32;
    const int sr = tid & 127, qd = __builtin_amdgcn_readfirstlane(tid >> 7);
    const bf16_t* zp = ZUV + (size_t)(r0 + sr) * 2048 + 1024 + g * 128 + qd * 32;
    const bf16_t* wp = SGUW + (size_t)(g * 128 + t) * 128 + 8 * hi;
    const bf16_t* zup = ZUV + (size_t)(r0 + t) * 2048 + g * 128;
    u32x4 w[4]; f32x4 sq[4]; bf16x8 wvv[8]; u32x2 zav[4], zbv[4];
#pragma unroll
    for (int j = 0; j < 4; ++j) { w[j] = *(const u32x4*)(zp + j * 8); sq[j] = *(const f32x4*)(SS2 + (size_t)(r0 + sr) * 16 + 4 * j); }
#pragma unroll
    for (int ks = 0; ks < 8; ++ks) wvv[ks] = *(const bf16x8*)(wp + 16 * ks);
#pragma unroll
    for (int j = 0; j < 4; ++j) { zav[j] = *(const u32x2*)(zup + 32 * cb0 + 8 * j + 4 * hi); zbv[j] = *(const u32x2*)(zup + 32 * cb0 + 8 * j + 4 * hi + 32); }
    const float bt = bs[g * 128 + t];
    asm volatile("" : "+v"(w[0]), "+v"(w[1]), "+v"(w[2]), "+v"(w[3]), "+v"(sq[0]), "+v"(sq[1]), "+v"(sq[2]), "+v"(sq[3]),
                 "+v"(wvv[0]), "+v"(wvv[1]), "+v"(wvv[2]), "+v"(wvv[3]), "+v"(wvv[4]), "+v"(wvv[5]), "+v"(wvv[6]), "+v"(wvv[7]),
                 "+v"(zav[0]), "+v"(zav[1]), "+v"(zav[2]), "+v"(zav[3]), "+v"(zbv[0]), "+v"(zbv[1]), "+v"(zbv[2]), "+v"(zbv[3]) :: "memory");
    {
        const float sm = ((sq[0].x + sq[0].y) + (sq[0].z + sq[0].w)) + ((sq[1].x + sq[1].y) + (sq[1].z + sq[1].w)) + ((sq[2].x + sq[2].y) + (sq[2].z + sq[2].w)) + ((sq[3].x + sq[3].y) + (sq[3].z + sq[3].w));
        const float rs = rsqrtf(sm * (1.0f / 1024.0f) + EPS);
#pragma unroll
        for (int j = 0; j < 4; ++j) {
            const float* gp = gn + g * 128 + qd * 32 + j * 8; const f32x4 g0 = *(const f32x4*)gp, g1 = *(const f32x4*)(gp + 4);
            const float v[8] = {bf_lo(w[j].x) * rs * g0.x, bf_hi(w[j].x) * rs * g0.y, bf_lo(w[j].y) * rs * g0.z, bf_hi(w[j].y) * rs * g0.w, bf_lo(w[j].z) * rs * g1.x, bf_hi(w[j].z) * rs * g1.y, bf_lo(w[j].w) * rs * g1.z, bf_hi(w[j].w) * rs * g1.w};
            LAS bf16_t* zt = ZT + (qd * 32 + j * 8) * 136 + sr;
#pragma unroll
            for (int e = 0; e < 8; ++e) zt[e * 136] = (bf16_t)(pk_bf16(v[e], 0.f) & 0xffffu);
        }
    }
    __syncthreads();
    f32x16 d0, d1;
#pragma unroll
    for (int r = 0; r < 16; ++r) { d0[r] = 0.f; d1[r] = 0.f; }
#pragma unroll
    for (int ks = 0; ks < 8; ++ks) {
        const bf16x8 z0 = *(const LAS bf16x8*)(ZT + (32 * cb0 + q32) * 136 + 16 * ks + 8 * hi);
        const bf16x8 z1 = *(const LAS bf16x8*)(ZT + (32 * (cb0 + 1) + q32) * 136 + 16 * ks + 8 * hi);
        d0 = __builtin_amdgcn_mfma_f32_32x32x16_bf16(z0, wvv[ks], d0, 0, 0, 0);
        d1 = __builtin_amdgcn_mfma_f32_32x32x16_bf16(z1, wvv[ks], d1, 0, 0, 0);
    }
    bf16_t* op = MIX + (size_t)(r0 + t) * DM + g * 128;
#pragma unroll
    for (int j = 0; j < 4; ++j) {
        const int c0 = 32 * cb0 + 8 * j + 4 * hi, c1 = c0 + 32;
        const u32x2 za = zav[j], zb = zbv[j];
        u32x2 wa, wb;
        wa.x = pk_bf16(bf_lo(za.x) * (d0[4 * j + 0] + bt), bf_hi(za.x) * (d0[4 * j + 1] + bt)); wa.y = pk_bf16(bf_lo(za.y) * (d0[4 * j + 2] + bt), bf_hi(za.y) * (d0[4 * j + 3] + bt));
        wb.x = pk_bf16(bf_lo(zb.x) * (d1[4 * j + 0] + bt), bf_hi(zb.x) * (d1[4 * j + 1] + bt)); wb.y = pk_bf16(bf_lo(zb.y) * (d1[4 * j + 2] + bt), bf_hi(zb.y) * (d1[4 * j + 3] + bt));
        *(u32x2*)(op + c0) = wa; *(u32x2*)(op + c1) = wb;
    }
    __syncthreads();
}
__device__ __forceinline__ void sgu_sample_unit(int b, int g, const bf16_t* ZUV, const float* SS2, const float* gn, const float* ws_f32, const float* bs, bf16_t* MIX, float* zs_out, LAS unsigned char* lds) {
    const int tid = fresh_tid();
    LAS float* Z = (LAS float*)lds; LAS float* rsl = (LAS float*)(lds + 16384);
    const int R0 = MP + b * 32;
    if (tid < 32) rsl[tid] = row_rstd(SS2, R0 + tid);
    __syncthreads();
    { const int s = tid >> 4, ch = tid & 15; const float rs = rsl[s];
      const u32x4 w = *(const u32x4*)(ZUV + (size_t)(R0 + s) * 2048 + 1024 + g * 128 + ch * 8);
      const f32x4 g0 = *(const f32x4*)(gn + g * 128 + ch * 8), g1 = *(const f32x4*)(gn + g * 128 + ch * 8 + 4);
      const f32x4 lo = (f32x4){bf_lo(w.x) * rs * g0.x, bf_hi(w.x) * rs * g0.y, bf_lo(w.y) * rs * g0.z, bf_hi(w.y) * rs * g0.w};
      const f32x4 hi4 = (f32x4){bf_lo(w.z) * rs * g1.x, bf_hi(w.z) * rs * g1.y, bf_lo(w.w) * rs * g1.z, bf_hi(w.w) * rs * g1.w};
      *(LAS f32x4*)(Z + s * 128 + ch * 8) = lo; *(LAS f32x4*)(Z + s * 128 + ch * 8 + 4) = hi4;
      float* zo = zs_out + (size_t)(b * 32 + s) * 1024 + g * 128 + ch * 8; *(f32x4*)zo = lo; *(f32x4*)(zo + 4) = hi4; }
    __syncthreads();
    { const int c = tid & 127, tq = tid >> 7;
      for (int ti = 0; ti < 8; ++ti) { const int t = tq * 8 + ti; float acc = bs[g * 128 + t]; const float* wrow = ws_f32 + (size_t)(g * 128 + t) * 128;
#pragma unroll 8
          for (int s = 0; s < 32; ++s) acc += wrow[s] * Z[s * 128 + c];
          const float zu = bf_lo((unsigned)ZUV[(size_t)(R0 + t) * 2048 + g * 128 + c]);
          MIX[(size_t)(R0 + t) * DM + g * 128 + c] = (bf16_t)(pk_bf16(zu * acc, 0.f) & 0xffffu); } }
    __syncthreads();
}

__device__ __forceinline__ void sres_phase(const bf16_t* A, const bf16_t* Bt, int K, const float* baseS, bf16_t* XB, float* SS, float alpha, int f32base, LAS unsigned char* lds) {
    const int tid = fresh_tid(), lane = tid & 63, wid = __builtin_amdgcn_readfirstlane(tid >> 6), fr = lane & 15, fq = lane >> 4;
    const int kh = wid >> 2, w4 = wid & 3, Kh = K >> 1;
    for (int blk = blockIdx.x; blk < 256; blk += gridDim.x) {
        const int cg = blk & 15, rs = ((blk >> 4) << 2) + w4;
        const int row = MP + rs * 16 + fr;
        const bf16_t* ap = A + (size_t)row * K + kh * Kh + fq * 8;
        const bf16_t* bp = Bt + (size_t)(cg * 64 + fr) * K + kh * Kh + fq * 8;
        f32x4 acc[4];
#pragma unroll
        for (int nf = 0; nf < 4; ++nf) acc[nf] = (f32x4){0.f, 0.f, 0.f, 0.f};
#pragma unroll 1
        for (int k0 = 0; k0 < Kh; k0 += 128) {
            bf16x8 av[4], bv[4][4];
#pragma unroll
            for (int uu = 0; uu < 4; ++uu) { av[uu] = *(const bf16x8*)(ap + k0 + uu * 32);
#pragma unroll
                for (int nf = 0; nf < 4; ++nf) bv[uu][nf] = *(const bf16x8*)(bp + (size_t)nf * 16 * K + k0 + uu * 32); }
            asm volatile("" : "+v"(av[0]), "+v"(av[1]), "+v"(av[2]), "+v"(av[3]),
                         "+v"(bv[0][0]), "+v"(bv[0][1]), "+v"(bv[0][2]), "+v"(bv[0][3]), "+v"(bv[1][0]), "+v"(bv[1][1]), "+v"(bv[1][2]), "+v"(bv[1][3]),
                         "+v"(bv[2][0]), "+v"(bv[2][1]), "+v"(bv[2][2]), "+v"(bv[2][3]), "+v"(bv[3][0]), "+v"(bv[3][1]), "+v"(bv[3][2]), "+v"(bv[3][3]) :: "memory");
#pragma unroll
            for (int uu = 0; uu < 4; ++uu)
#pragma unroll
                for (int nf = 0; nf < 4; ++nf) acc[nf] = __builtin_amdgcn_mfma_f32_16x16x32_bf16(bv[uu][nf], av[uu], acc[nf], 0, 0, 0);
        }
        LAS f32x4* red = (LAS f32x4*)lds + (w4 * 4) * 64 + lane;
        if (kh == 1) {
#pragma unroll
            for (int nf = 0; nf < 4; ++nf) red[nf * 64] = acc[nf];
        }
        __syncthreads();
        if (kh == 0) {
            float ss = 0.f;
#pragma unroll
            for (int nf = 0; nf < 4; ++nf) {
                const f32x4 a2 = acc[nf] + red[nf * 64];
                const int col = cg * 64 + nf * 16 + 4 * fq; bf16_t* xp = XB + (size_t)row * DM + col; f32x4 b;
                if (f32base) b = *(const f32x4*)(baseS + (size_t)(row - MP) * DM + col);
                else { const u32x2 w = *(const u32x2*)xp; b = (f32x4){bf_lo(w.x), bf_hi(w.x), bf_lo(w.y), bf_hi(w.y)}; }
                const f32x4 x = b + a2 * alpha;
                u32x2 w; w.x = pk_bf16(x[0], x[1]); w.y = pk_bf16(x[2], x[3]); *(u32x2*)xp = w;
                ss += (x[0] * x[0] + x[1] * x[1]) + (x[2] * x[2] + x[3] * x[3]);
            }
            ss += __shfl_xor(ss, 16); ss += __shfl_xor(ss, 32);
            if (fq == 0) SS[(size_t)row * 16 + cg] = ss;
        }
        __syncthreads();
    }
}

#define XB_TMO      128
#define XB_XCNT(j)  (256  + 64 * (j))
#define XB_XSUB(j)  (1280 + 64 * (j))
#define XB_XGEN(j)  (2304 + 64 * (j))
#define XB_TOP      3328
#define XB_TOPGEN   3392
#define XCD_BAR_WORDS 3456
#define XB_SPIN_CAP (1u << 22)
__device__ __forceinline__ unsigned xb_ld(unsigned* p)              { return __hip_atomic_load(p, __ATOMIC_RELAXED, __HIP_MEMORY_SCOPE_AGENT); }
__device__ __forceinline__ unsigned xb_add(unsigned* p, unsigned v) { return __hip_atomic_fetch_add(p, v, __ATOMIC_RELAXED, __HIP_MEMORY_SCOPE_AGENT); }
__device__ __forceinline__ unsigned xb_xcc_id() { return (unsigned)__builtin_amdgcn_s_getreg((3 << 11) | 20) & 0xFu; }
#define XB_SPIN(cond, bar) do { unsigned _sp = 0; while (cond) { __builtin_amdgcn_s_sleep(1); \
    if ((++_sp & 255u) == 0u) { if (xb_ld(&(bar)[XB_TMO])) break; if (_sp > XB_SPIN_CAP) { atomicAdd(&(bar)[XB_TMO], 1u); break; } } } } while (0)
constexpr int LDS_XB = LDS_BYTES - 64;
__device__ __forceinline__ void xcd_barrier_complete(unsigned* bar, unsigned x, unsigned& nloc, unsigned& nx) {
    const unsigned G = gridDim.x * gridDim.y * gridDim.z;
    unsigned sum, cnt, mine, sp = 0u;
    for (;;) {
        sum = 0u; cnt = 0u; mine = 0u;
#pragma unroll
        for (unsigned j = 0; j < 16; ++j) { const unsigned c = xb_ld(&bar[XB_XCNT(j)]); sum += c; cnt += (c > 0u) ? 1u : 0u; mine = (j == x) ? c : mine; }
        if (sum == G) break;
        __builtin_amdgcn_s_sleep(1);
        if ((++sp & 255u) == 0u) { if (xb_ld(&bar[XB_TMO])) break; if (sp > XB_SPIN_CAP) { atomicAdd(&bar[XB_TMO], 1u); break; } }
    }
    nloc = mine > 0u ? mine : 1u; nx = cnt > 0u ? cnt : 1u;
}
__device__ __forceinline__ void gsync(unsigned* bar, LAS unsigned char* lds) {
    asm volatile("s_waitcnt vmcnt(0) lgkmcnt(0)" ::: "memory");
    __syncthreads();
    if (threadIdx.x == 0) {
        volatile LAS unsigned* st = (volatile LAS unsigned*)(lds + LDS_XB);
        __builtin_amdgcn_s_waitcnt(0);
        unsigned nloc = st[0], nx = st[1]; const unsigned x = st[2];
        if (nloc == 0u) { xcd_barrier_complete(bar, x, nloc, nx); st[0] = nloc; st[1] = nx; }
        const unsigned old = xb_add(&bar[XB_XSUB(x)], 1u);
        const unsigned gen = old / nloc;
        if (old + 1u == (gen + 1u) * nloc) {
            __builtin_amdgcn_fence(__ATOMIC_RELEASE, "agent");
            asm volatile("s_waitcnt vmcnt(0)" ::: "memory");
            const unsigned og = xb_add(&bar[XB_TOP], 1u);
            const unsigned tg = og / nx;
            if (og + 1u == (tg + 1u) * nx) xb_add(&bar[XB_TOPGEN], 1u);
            else XB_SPIN(xb_ld(&bar[XB_TOPGEN]) == tg, bar);
            __builtin_amdgcn_fence(__ATOMIC_ACQUIRE, "agent");
            xb_add(&bar[XB_XGEN(x)], 1u);
            asm volatile("s_waitcnt vmcnt(0)" ::: "memory");
        } else {
            XB_SPIN(xb_ld(&bar[XB_XGEN(x)]) == gen, bar);
            __builtin_amdgcn_fence(__ATOMIC_ACQUIRE, "agent");
            asm volatile("s_waitcnt vmcnt(0)" ::: "memory");
        }
    }
    __syncthreads();
}

__global__ void __launch_bounds__(512) fwd_megakernel(Args a) {
    extern __shared__ __attribute__((aligned(16))) unsigned char lds_raw[];
    LAS unsigned char* lds = (LAS unsigned char*)lds_raw;
    cg::grid_group grid = cg::this_grid();
    const int G = gridDim.x, bx = blockIdx.x;
    unsigned char* ws = a.ws; float* out = a.out;
    bf16_t* W1 = (bf16_t*)(ws + WS_W1); bf16_t* W2 = (bf16_t*)(ws + WS_W2);
    bf16_t* XB = (bf16_t*)(ws + WS_XB); bf16_t* MIX = (bf16_t*)(ws + WS_MIX); bf16_t* R1 = (bf16_t*)(ws + WS_R1);
    float* SS = (float*)(ws + WS_SS); float* SS2 = (float*)(ws + WS_SS2);
    float* X = out + OFF_Y;

    unsigned* bar = (unsigned*)(ws + WS_BAR);
    if (threadIdx.x == 0) { volatile LAS unsigned* st = (volatile LAS unsigned*)(lds + LDS_XB); const unsigned x = xb_xcc_id(); st[0] = 0u; st[1] = 0u; st[2] = x; (void)xb_add(&bar[XB_XCNT(x)], 1u); }
    grid.sync();
    p0_phase(a, lds);
    gsync(bar, lds);

    for (int s = 0; s < 4; ++s) {
        const int l = s >> 1, j = s & 1;
        if (j == 1) {
            if (l == 0) {
                { pg8::Gemm g{XB, (const bf16_t*)(ws + WS_WEIN), MT, 2048, DM}; pg8::StaticOrder S; S.init(MT, 2048, G, bx);
                  pg8::EpiProjEven E{R1, SS, out};
                  pg8::gemm_phase<pg8::EpiProjEven, pg8::StaticOrder, true, true>(lds, g, S, E); }
                for (int i = (G == 256 ? bx - 32 : bx + G); i >= 0 && i < MT / 256; i += (G == 256 ? 224 : G)) f_unit(i, XB, (const bf16_t*)(ws + WS_WF), SS, a.in[10], out);
                gsync(bar, lds);
                for (int bh = bx; bh < 256; bh += G) {
                    const int b = bh >> 3, h = bh & 7;
                    { const float* lf = out + OFF_FP + (size_t)b * SEQ * 8 + h; const int t = 4 * fresh_tid();
                      scan2048(lf[(size_t)(t + 0) * 8], lf[(size_t)(t + 1) * 8], lf[(size_t)(t + 2) * 8], lf[(size_t)(t + 3) * 8], lds); }
                    for (int qb = 7; qb >= 0; --qb) {
                        AttnJob J; J.Qrow0 = R1 + (size_t)(b * SEQ + qb * 256) * 2048 + h * 64; J.Orow0 = MIX + (size_t)(b * SEQ + qb * 256) * DM + h * 64;
                        J.nqw = 8; J.qpos0 = qb * 256; J.NT = 4 * (qb + 1); J.mode = 0; J.Kb = R1 + (size_t)(b * SEQ) * 2048 + 512 + h * 64; J.cK = nullptr; J.cV = nullptr;
                        attn_unit(J, lds);
                    }
                }
                for (int bh = bx; bh < 256; bh += G) {
                    const int b = bh >> 3, h = bh & 7;
                    { const float* cf = a.in[4] + (size_t)b * PAST * 8 + h; const float* nf = out + OFF_FS + (size_t)b * TS * 8 + h; float v[4]; const int tid = fresh_tid();
#pragma unroll
                      for (int e = 0; e < 4; ++e) { const int t = 4 * tid + e; v[e] = t < PAST ? cf[(size_t)t * 8] : (t < PAST + TS ? nf[(size_t)(t - PAST) * 8] : 0.f); }
                      scan2048(v[0], v[1], v[2], v[3], lds); }
                    AttnJob J; J.Qrow0 = R1 + (size_t)(MP + b * TS) * 2048 + h * 64; J.Orow0 = MIX + (size_t)(MP + b * TS) * DM + h * 64;
                    J.nqw = 1; J.qpos0 = PAST; J.NT = 17; J.mode = 1; J.Kb = R1 + (size_t)(MP + b * TS) * 2048 + 512 + h * 64;
                    J.cK = a.in[2] + (size_t)b * PAST * 512 + h * 64; J.cV = a.in[3] + (size_t)b * PAST * 512 + h * 64;
                    attn_unit(J, lds);
                }
                for (int u = bx; u < 520 * 4; u += G) pool_unit(u >> 2, u & 3, R1, a.in[5], (const bf16_t*)(ws + WS_POOLWT), MIX, lds);
                gsync(bar, lds);
                { pg8::Gemm g{MIX, (const bf16_t*)(ws + WS_WEOUT), MP, DM, DM}; pg8::StaticOrder S; S.init(MP, DM, G, bx);
                  pg8::EpiResidual E{nullptr, nullptr, XB, SS, 1.0f, 0};
                  pg8::gemm_phase<pg8::EpiResidual, pg8::StaticOrder, true, true>(lds, g, S, E); }
                sres_phase(MIX, (const bf16_t*)(ws + WS_WEOUT), DM, nullptr, XB, SS, 1.0f, 0, lds);
                gsync(bar, lds);
            } else {
                { pg8::Gemm g{XB, (const bf16_t*)(ws + WS_WSIN), MT, 2048, DM}; pg8::StaticOrder S; S.init(MT, 2048, G, bx);
                  pg8::EpiSguProj E{R1, SS, SS2};
                  pg8::gemm_phase<pg8::EpiSguProj, pg8::StaticOrder, true, true>(lds, g, S, E); }
                gsync(bar, lds);
                for (int u = bx; u < 512 * 8; u += G) sgu_unit(511 - (u >> 3), u & 7, R1, SS2, a.in[15], (const bf16_t*)(ws + WS_SGUW), a.in[17], MIX, lds);
                for (int u = bx; u < 32 * 8; u += G) sgu_sample_unit(u >> 3, u & 7, R1, SS2, a.in[15], a.in[16], a.in[17], MIX, out + OFF_ZS, lds);
                gsync(bar, lds);
                { pg8::Gemm g{MIX, (const bf16_t*)(ws + WS_WSOUT), MP, DM, DM}; pg8::StaticOrder S; S.init(MP, DM, G, bx);
                  pg8::EpiResidual E{nullptr, nullptr, XB, SS, 1.0f, 0};
                  pg8::gemm_phase<pg8::EpiResidual, pg8::StaticOrder, true, true>(lds, g, S, E); }
                sres_phase(MIX, (const bf16_t*)(ws + WS_WSOUT), DM, nullptr, XB, SS, 1.0f, 0, lds);
                gsync(bar, lds);
            }
        }
        { pg8::Gemm g{XB, W1 + (size_t)s * NFF * DM, MT, NFF, DM}; pg8::StaticOrder S; S.init(MT, NFF, G, bx);
          pg8::EpiSwiGLU E{R1, SS};
          pg8::gemm_phase<pg8::EpiSwiGLU, pg8::StaticOrder, true, true>(lds, g, S, E); }
        if (s == 0 && G == 256 && bx >= 88)
            p0_weight_items(a, lds, 1, 2, (bx - 88) * 8 + __builtin_amdgcn_readfirstlane(fresh_tid() >> 6), 168 * 8);
        gsync(bar, lds);
        { pg8::Gemm g{R1, W2 + (size_t)s * DM * DFF, MP, DM, DFF}; pg8::StaticOrder S; S.init(MP, DM, G, bx); S.rev = 1;
          pg8::EpiResidual E{a.in[0], a.in[1], XB, SS, 0.5f, s == 0 ? 1 : 0};
          pg8::gemm_phase<pg8::EpiResidual, pg8::StaticOrder, true, true>(lds, g, S, E); }
        sres_phase(R1, W2 + (size_t)s * DM * DFF, DFF, a.in[1], XB, SS, 0.5f, s == 0 ? 1 : 0, lds);
        gsync(bar, lds);
    }
    {
        const int tid = fresh_tid(), lane = tid & 63, wid = __builtin_amdgcn_readfirstlane(tid >> 6);
        const int gw = bx * 8 + wid, NGW = G * 8; const float* fg = a.in[19];
        f32x4 gv[4];
#pragma unroll
        for (int jx = 0; jx < 4; ++jx) gv[jx] = *(const f32x4*)(fg + (lane + 64 * jx) * 4);
        for (int row0 = gw; row0 < MT; row0 += 4 * NGW) {
            u32x2 w[4][4];
#pragma unroll
            for (int i = 0; i < 4; ++i) { const int row = min(row0 + i * NGW, MT - 1);
#pragma unroll
                for (int jx = 0; jx < 4; ++jx) w[i][jx] = __builtin_nontemporal_load((const u32x2*)(XB + (size_t)row * DM + (lane + 64 * jx) * 4)); }
            asm volatile("" : "+v"(w[0][0]), "+v"(w[0][1]), "+v"(w[0][2]), "+v"(w[0][3]), "+v"(w[1][0]), "+v"(w[1][1]), "+v"(w[1][2]), "+v"(w[1][3]),
                         "+v"(w[2][0]), "+v"(w[2][1]), "+v"(w[2][2]), "+v"(w[2][3]), "+v"(w[3][0]), "+v"(w[3][1]), "+v"(w[3][2]), "+v"(w[3][3]) :: "memory");
#pragma unroll
            for (int i = 0; i < 4; ++i) { const int row = row0 + i * NGW; if (row < MT) { f32x4 v[4]; float ss = 0.f;
#pragma unroll
                for (int jx = 0; jx < 4; ++jx) { v[jx] = (f32x4){bf_lo(w[i][jx].x), bf_hi(w[i][jx].x), bf_lo(w[i][jx].y), bf_hi(w[i][jx].y)};
                    ss += (v[jx].x * v[jx].x + v[jx].y * v[jx].y) + (v[jx].z * v[jx].z + v[jx].w * v[jx].w); }
                ss = wave_sum(ss); const float r = rsqrtf(ss * (1.0f / 1024.0f) + EPS); float* yr = X + (size_t)row * DM;
#pragma unroll
                for (int jx = 0; jx < 4; ++jx) __builtin_nontemporal_store(v[jx] * r * gv[jx], (f32x4*)(yr + (lane + 64 * jx) * 4)); } }
        }
    }
}

extern "C" void kernel_launch(void* const* d_in, const int* in_sizes, int n_in, void* d_out, int out_size, void* d_ws, size_t ws_size, hipStream_t stream) {
    static int grid = 0;
    if (grid == 0) {
        if (n_in != 20 || ws_size < WS_END) { fprintf(stderr, "kernel_launch: unexpected inputs (n_in %d, ws %zu, need %zu)\n", n_in, ws_size, (size_t)WS_END); grid = -1; return; }
        int dev = 0, cus = 0, per_cu = 0;
        hipGetDevice(&dev);
        hipDeviceGetAttribute(&cus, hipDeviceAttributeMultiprocessorCount, dev);
        if (hipFuncSetAttribute((const void*)fwd_megakernel, hipFuncAttributeMaxDynamicSharedMemorySize, LDS_BYTES) != hipSuccess) { fprintf(stderr, "kernel_launch: hipFuncSetAttribute failed\n"); grid = -1; return; }
        if (hipOccupancyMaxActiveBlocksPerMultiprocessor(&per_cu, (const void*)fwd_megakernel, 512, LDS_BYTES) != hipSuccess || per_cu < 1) { fprintf(stderr, "kernel_launch: occupancy query gives %d\n", per_cu); per_cu = 1; }
        (void)hipGetLastError();
        grid = cus * per_cu;
    }
    if (grid < 0) return;
    if (hipMemsetAsync((char*)d_ws + WS_BAR, 0, 16384, stream) != hipSuccess) { fprintf(stderr, "kernel_launch: memset failed\n"); return; }
    Args a{};
    for (int i = 0; i < 20; ++i) a.in[i] = (const float*)d_in[i];
    a.out = (float*)d_out; a.ws = (unsigned char*)d_ws;
    void* args[] = {&a};
    hipError_t e = hipLaunchCooperativeKernel((const void*)fwd_megakernel, dim3(grid), dim3(512), args, LDS_BYTES, stream);
    if (e != hipSuccess) fprintf(stderr, "cooperative launch failed: %s (grid %d)\n", hipGetErrorString(e), grid);
}
```
